# Optimizing an MI355X kernel written in HIP

```python
import jax, jax.numpy as jnp
from jax import lax
import numpy as np

D_MODEL = 1024
BATCH = 8
SEQ = 2048
DEPTH = 4
DEC_BATCH = 128
DEC_SEQ = 8
PAST_LEN = 16384
PAGE_SIZE = 128

D_MIX = 2 * D_MODEL
W_POOL = D_MIX // 2
W_LRU = D_MIX - W_POOL
POOL_WINDOWS = (2, 4, 8, 16)
N_POOL_GROUPS = 4
POOL_GROUP = W_POOL // N_POOL_GROUPS
POOL_BUF = 15
LRU_HEADS = 8
LRU_HEAD_DIM = W_LRU // LRU_HEADS
CONV_WIDTH = 4
CONV_BUF = CONV_WIDTH - 1
LRU_C = 8.0
NORM_EPS = 1e-6
D_IN = 2 * W_POOL + 2 * W_LRU

kernel_name = "hymba_pool_rglru_decoder_step"


def rms_norm(x, g):
    xf = x.astype(jnp.float32)
    y = xf * lax.rsqrt(jnp.mean(xf * xf, axis=-1, keepdims=True) + NORM_EPS)
    return (y * g.astype(jnp.float32)).astype(x.dtype)


def pool_mixer(v, buf, start_pos, pool_w, pool_scale):
    B, T = v.shape[0], v.shape[1]
    ext = jnp.concatenate([buf.astype(jnp.float32), v.astype(jnp.float32)], axis=1)
    cs0 = jnp.concatenate([jnp.zeros((B, 1, W_POOL), jnp.float32), jnp.cumsum(ext, axis=1)], axis=1)
    pos = start_pos + jnp.arange(T, dtype=jnp.int32)
    xcur = ext[:, POOL_BUF:, :]
    outs = []
    for g in range(N_POOL_GROUPS):
        w = POOL_WINDOWS[g]
        c0, c1 = g * POOL_GROUP, (g + 1) * POOL_GROUP
        hi = cs0[:, POOL_BUF + 1:POOL_BUF + 1 + T, c0:c1]
        lo = cs0[:, POOL_BUF + 1 - w:POOL_BUF + 1 - w + T, c0:c1]
        cnt = jnp.minimum(pos + 1, w).astype(jnp.float32)[None, :, None]
        outs.append((hi - lo) / cnt - xcur[:, :, c0:c1])
    d = jnp.stack(outs, axis=2)
    y = jnp.einsum('btgc,gcd->btgd', d, pool_w.astype(jnp.float32)).reshape(B, T, W_POOL)
    y = y * pool_scale.astype(jnp.float32)[None, None, :]
    new_buf = ext[:, T:, :]
    return y.astype(v.dtype), new_buf.astype(buf.dtype)


def causal_conv(u, buf, conv_w, conv_b):
    T = u.shape[1]
    ext = jnp.concatenate([buf.astype(jnp.float32), u.astype(jnp.float32)], axis=1)
    cw = conv_w.astype(jnp.float32)
    y = conv_b.astype(jnp.float32)[None, None, :]
    for k in range(CONV_WIDTH):
        y = y + ext[:, k:k + T, :] * cw[k][None, None, :]
    return y.astype(u.dtype), ext[:, T:, :].astype(buf.dtype)


def rg_lru(xs, h0, start_pos, wa, ba, wx, bx, lam):
    B, T = xs.shape[0], xs.shape[1]
    xf = xs.astype(jnp.float32)
    xh = xf.reshape(B, T, LRU_HEADS, LRU_HEAD_DIM)
    r = jax.nn.sigmoid(jnp.einsum('bthi,hij->bthj', xh, wa.astype(jnp.float32)).reshape(B, T, W_LRU)
                       + ba.astype(jnp.float32)[None, None, :])
    gi = jax.nn.sigmoid(jnp.einsum('bthi,hij->bthj', xh, wx.astype(jnp.float32)).reshape(B, T, W_LRU)
                        + bx.astype(jnp.float32)[None, None, :])
    log_a = -LRU_C * r * jax.nn.softplus(-lam.astype(jnp.float32))[None, None, :]
    a = jnp.exp(log_a)
    mult = jnp.sqrt(jnp.maximum(-jnp.expm1(2.0 * log_a), 1e-12))
    pos = start_pos + jnp.arange(T, dtype=jnp.int32)
    is_start = (pos == 0).astype(jnp.float32)[None, :, None]
    mult = is_start + (1.0 - is_start) * mult
    u = xf * gi * mult

    def step(h, au):
        a_t, u_t = au
        h_new = a_t * h + u_t
        return h_new, h_new

    hT, hs = lax.scan(step, h0.astype(jnp.float32), (jnp.swapaxes(a, 0, 1), jnp.swapaxes(u, 0, 1)))
    return jnp.swapaxes(hs, 0, 1).astype(xs.dtype), hT.astype(h0.dtype)


def layer(x, pool_buf, conv_buf, h0, start_pos, norm_pre, norm_post, w_in, pool_w, pool_scale,
          conv_w, conv_b, lru_wa, lru_ba, lru_wx, lru_bx, lru_lam, w_out):
    xn = rms_norm(x, norm_pre)
    z = jnp.einsum('btd,de->bte', xn, w_in.astype(xn.dtype))
    v_pool = z[:, :, 0:W_POOL]
    g_pool = z[:, :, W_POOL:2 * W_POOL]
    u_lru = z[:, :, 2 * W_POOL:2 * W_POOL + W_LRU]
    g_lru = z[:, :, 2 * W_POOL + W_LRU:D_IN]
    y_pool, new_pool = pool_mixer(v_pool, pool_buf, start_pos, pool_w, pool_scale)
    xs, new_conv = causal_conv(u_lru, conv_buf, conv_w, conv_b)
    y_lru, new_h = rg_lru(xs, h0, start_pos, lru_wa, lru_ba, lru_wx, lru_bx, lru_lam)
    mixed = jnp.concatenate([y_pool * jax.nn.silu(g_pool), y_lru * jax.nn.silu(g_lru)], axis=-1)
    out = jnp.einsum('bte,ed->btd', mixed, w_out.astype(mixed.dtype))
    return x + rms_norm(out, norm_post), new_pool, new_conv, new_h


def setup_inputs(seed: int = 0) -> dict:
    key = jax.random.key(seed)
    ks = jax.random.split(key, 20)
    f32 = jnp.float32
    a0 = jax.random.uniform(ks[15], (DEPTH, W_LRU), f32, 0.9, 0.999)
    a_base = a0 ** (1.0 / LRU_C)
    return {
        "x_prompt": jax.random.normal(ks[0], (BATCH, SEQ, D_MODEL), f32),
        "x_sample": jax.random.normal(ks[1], (DEC_BATCH, DEC_SEQ, D_MODEL), f32),
        "state_pool": jax.random.normal(ks[2], (DEPTH, DEC_BATCH, POOL_BUF, W_POOL), f32),
        "state_conv": jax.random.normal(ks[3], (DEPTH, DEC_BATCH, CONV_BUF, W_LRU), f32),
        "state_lru": 0.5 * jax.random.normal(ks[4], (DEPTH, DEC_BATCH, W_LRU), f32),
        "norm_pre": 1.0 + 0.1 * jax.random.normal(ks[5], (DEPTH, D_MODEL), f32),
        "norm_post": 1.0 + 0.1 * jax.random.normal(ks[6], (DEPTH, D_MODEL), f32),
        "w_in": jax.random.normal(ks[7], (DEPTH, D_MODEL, D_IN), f32) * D_MODEL ** -0.5,
        "pool_w": jax.random.normal(ks[8], (DEPTH, N_POOL_GROUPS, POOL_GROUP, POOL_GROUP), f32) * POOL_GROUP ** -0.5,
        "pool_scale": 1.0 + 0.1 * jax.random.normal(ks[9], (DEPTH, W_POOL), f32),
        "conv_w": jax.random.normal(ks[10], (DEPTH, CONV_WIDTH, W_LRU), f32) * CONV_WIDTH ** -0.5,
        "conv_b": 0.02 * jax.random.normal(ks[11], (DEPTH, W_LRU), f32),
        "lru_wa": jax.random.normal(ks[12], (DEPTH, LRU_HEADS, LRU_HEAD_DIM, LRU_HEAD_DIM), f32) * LRU_HEAD_DIM ** -0.5,
        "lru_ba": 0.02 * jax.random.normal(ks[13], (DEPTH, W_LRU), f32),
        "lru_wx": jax.random.normal(ks[14], (DEPTH, LRU_HEADS, LRU_HEAD_DIM, LRU_HEAD_DIM), f32) * LRU_HEAD_DIM ** -0.5,
        "lru_bx": 0.02 * jax.random.normal(ks[16], (DEPTH, W_LRU), f32),
        "lru_lam": jnp.log(a_base) - jnp.log1p(-a_base),
        "w_out": jax.random.normal(ks[17], (DEPTH, D_MIX, D_MODEL), f32) * D_MIX ** -0.5,
    }


def reference(x_prompt, x_sample, state_pool, state_conv, state_lru, norm_pre, norm_post, w_in,
              pool_w, pool_scale, conv_w, conv_b, lru_wa, lru_ba, lru_wx, lru_bx, lru_lam, w_out):
    n_prompt = x_prompt.shape[0]
    xp = x_prompt
    xq = x_sample
    pp, cp, hp, psm, csm, hsm = [], [], [], [], [], []
    for l in range(DEPTH):
        params = (norm_pre[l], norm_post[l], w_in[l], pool_w[l], pool_scale[l], conv_w[l], conv_b[l],
                  lru_wa[l], lru_ba[l], lru_wx[l], lru_bx[l], lru_lam[l], w_out[l])
        zero_pool = jnp.zeros((n_prompt, POOL_BUF, W_POOL), state_pool.dtype)
        zero_conv = jnp.zeros((n_prompt, CONV_BUF, W_LRU), state_conv.dtype)
        zero_h = jnp.zeros((n_prompt, W_LRU), state_lru.dtype)
        xp, pool_p, conv_p, h_p = layer(xp, zero_pool, zero_conv, zero_h, 0, *params)
        pp.append(pool_p)
        cp.append(conv_p)
        hp.append(h_p)
        xq, pool_s, conv_s, h_s = layer(xq, state_pool[l], state_conv[l], state_lru[l], PAST_LEN, *params)
        psm.append(pool_s)
        csm.append(conv_s)
        hsm.append(h_s)
    new_pool_prompt = jnp.stack(pp, axis=0)
    new_conv_prompt = jnp.stack(cp, axis=0)
    new_lru_prompt = jnp.stack(hp, axis=0)
    new_pool_sample = jnp.stack(psm, axis=0)
    new_conv_sample = jnp.stack(csm, axis=0)
    new_lru_sample = jnp.stack(hsm, axis=0)
    return (xp, xq, new_pool_prompt, new_conv_prompt, new_lru_prompt, new_pool_sample, new_conv_sample, new_lru_sample)
```

```cpp
#include <hip/hip_runtime.h>
#include <hip/hip_cooperative_groups.h>
#include <cstdio>
namespace cg = cooperative_groups;
namespace pg8 {
#define PG8_LAS __attribute__((address_space(3)))
typedef unsigned short bf16_t;
typedef short bf16x8 __attribute__((ext_vector_type(8)));
typedef float f32x4 __attribute__((ext_vector_type(4)));
typedef unsigned u32x4 __attribute__((ext_vector_type(4)));
constexpr int BM = 256, BK = 64, HALF = 128, HTB = HALF * BK * 2  , STAGE_BYTES = 8 * HTB, NXCD = 8, WGM = 8;

__host__ __device__ __forceinline__ int lds_byte(int r, int c) { const int st = (r >> 4) * 2 + (c >> 5), rr = r & 15, cc = c & 31, ob = rr * 64 + cc * 2; return st * 1024 + (ob ^ (((ob >> 9) & 1) << 5)); }
__host__ __device__ __forceinline__ void stage_rc(int b, int& R, int& C) { const int st = b / 1024, sb = b % 1024, swz = sb ^ (((sb >> 9) & 1) << 5); R = (st >> 1) * 16 + swz / 64; C = (st & 1) * 32 + (swz % 64) / 2; }
__host__ __device__ __forceinline__ int perm32(int rho) { const int n = rho >> 4, i = rho & 15; return 8 * (i >> 2) + 4 * n + (i & 3); }

struct Unit { int pm, pn; };
struct Gemm { const bf16_t* A; const bf16_t* Bt; int M, N; };

struct StaticOrder {
    int nM, nN, nwg, G, c;
    __host__ __device__ void init(int M, int N, int G_, int c_) { nM = M / BM; nN = N / BM; nwg = nM * nN; G = G_; c = c_; }
    __host__ __device__ bool next(int i, Unit& u) const {
        const long L = (long)i * G + c; if (L >= nwg) return false;
        int wgid = (int)L; { const int q = nwg / NXCD, r = nwg % NXCD, xcd = wgid % NXCD, off = wgid / NXCD; wgid = (xcd < r ? xcd * (q + 1) : r * (q + 1) + (xcd - r) * q) + off; }
        const int nig = WGM * nN, gid = wgid / nig, fm = gid * WGM, gsz = (nM - fm) < WGM ? (nM - fm) : WGM;
        u.pm = fm + ((wgid % nig) % gsz); u.pn = (wgid % nig) / gsz; return true;
    }
    __device__ __forceinline__ void a_ready(const Unit&) const {}
    __device__ __forceinline__ void done(const Unit&) const {}
};

__device__ __forceinline__ unsigned cvt_pk_bf16(float lo, float hi) { unsigned r; asm volatile("v_cvt_pk_bf16_f32 %0, %1, %2" : "=v"(r) : "v"(lo), "v"(hi)); return r; }
typedef float f32x2 __attribute__((ext_vector_type(2)));
__device__ __forceinline__ f32x2 gelu_pk(f32x2 v) {
    const f32x2 av = __builtin_elementwise_abs(v), d = av * 0.2316418882f + 1.0f;
    f32x2 t; t.x = __builtin_amdgcn_rcpf(d.x); t.y = __builtin_amdgcn_rcpf(d.y);
    f32x2 q = t * 0.5307027145f + (-0.7265760135f); q = q * t + 0.7107068705f; q = q * t + (-0.142248368f); q = q * t + 0.127414796f; q = q * t;
    const f32x2 s = (v * v) * (-0.72134752044f);
    f32x2 e; e.x = __builtin_amdgcn_exp2f(s.x); e.y = __builtin_amdgcn_exp2f(s.y);
    const f32x2 m = v * (q * e), r = v - m;
    f32x2 o; o.x = v.x < 0.f ? m.x : r.x; o.y = v.y < 0.f ? m.y : r.y; return o;
}

template <int ACT  > struct EpiBf16 {
    static constexpr bool PERM = true, AFTER_DRAIN = false; static_assert(ACT == 0 || ACT == 1, "EpiBf16: ACT is 0 (none) or 1 (gelu_pk)");
    bf16_t* O; int ldc; const float* bias; int split_cols; size_t split_stride; float scale0;
    __device__ __forceinline__ void operator()(const f32x4 (&acc)[2][2][4][2], const Unit& u, int wr, int wc, int fr, int fq) const {
        const int row0 = u.pm * BM + wr * 64 + fr; int colt = u.pn * BM; bf16_t* base = O;
        float sc = 1.f; if (split_cols) { const int t = colt / split_cols; base += (size_t)t * split_stride; colt -= t * split_cols; if (t == 0) sc = scale0; }
        const int col0 = colt + wc * 32 + 8 * fq, bcol0 = u.pn * BM + wc * 32 + 8 * fq;
        f32x4 bv[2][2];
#pragma unroll
        for (int bj = 0; bj < 2; ++bj)
#pragma unroll
            for (int n = 0; n < 2; ++n) bv[bj][n] = bias ? *(const f32x4*)(bias + bcol0 + bj * HALF + 4 * n) : (f32x4){0.f, 0.f, 0.f, 0.f};
#pragma unroll
        for (int ai = 0; ai < 2; ++ai)
#pragma unroll
            for (int m = 0; m < 4; ++m) { bf16_t* rowp = base + (size_t)(row0 + ai * HALF + m * 16) * ldc + col0;
#pragma unroll
                for (int bj = 0; bj < 2; ++bj) { f32x4 v0 = acc[ai][bj][m][0] + bv[bj][0], v1 = acc[ai][bj][m][1] + bv[bj][1];
                    if (ACT == 1) { f32x2 a = gelu_pk((f32x2){v0[0], v0[1]}), b = gelu_pk((f32x2){v0[2], v0[3]}), c = gelu_pk((f32x2){v1[0], v1[1]}), d = gelu_pk((f32x2){v1[2], v1[3]});
                        v0 = (f32x4){a.x, a.y, b.x, b.y}; v1 = (f32x4){c.x, c.y, d.x, d.y}; }
                    v0 = v0 * sc; v1 = v1 * sc; u32x4 w; w.x = cvt_pk_bf16(v0[0], v0[1]); w.y = cvt_pk_bf16(v0[2], v0[3]); w.z = cvt_pk_bf16(v1[0], v1[1]); w.w = cvt_pk_bf16(v1[2], v1[3]);
                    *(u32x4*)(rowp + bj * HALF) = w; } }
    }
};
template <class Epi, class Sched, int KK, int LDA, int LDB, bool ALIGN_EPI = false, bool SP2 = false>
__device__ __forceinline__ void gemm_phase(PG8_LAS unsigned char* lds, const Gemm g, const Sched& S, const Epi& E, const int tid) {
    const int wid = __builtin_amdgcn_readfirstlane(tid >> 6), lane = tid & 63, wr = wid >> 2, wc = wid & 3, fr = lane & 15, fq = lane >> 4;
    constexpr int K = KK, nt = K / BK;
    unsigned voffA[2], voffB[2];
#pragma unroll
    for (int i = 0; i < 2; ++i) { int R, C; stage_rc(tid * 16 + i * 8192, R, C); const int Rb = Epi::PERM ? ((R & ~31) + perm32(R & 31)) : R;
        voffA[i] = (unsigned)(R * LDA + C) * 2u; voffB[i] = (unsigned)(Rb * LDB + C) * 2u; }
    const size_t kstep = (size_t)(BK * 2);
    constexpr size_t hstepB = (size_t)HALF * LDB * 2, hstepA = (size_t)HALF * LDA * 2;
    constexpr size_t tstepB = 2 * hstepB, tstepA = 2 * hstepA;
    const unsigned ldsw = (unsigned)wid * 1024u;
    const int aoff = lds_byte(wr * 64 + fr, fq * 8), boff = lds_byte(wc * 32 + fr, fq * 8);
#define PG8_SA(b, h) (((b) * 2 + (h)) * HTB)
#define PG8_SB(b, h) ((4 + (b) * 2 + (h)) * HTB)
#define PG8_STAGE(bufoff, gbase, voff) do { _Pragma("unroll") for (int _i = 0; _i < 2; ++_i) \
        __builtin_amdgcn_global_load_lds((const unsigned*)((const char*)(gbase) + (voff)[_i]), (PG8_LAS unsigned*)(lds + (bufoff) + ldsw + _i * 8192), 16, 0, 0); } while (0)
#define PG8_LDA(dst, b, h) do { _Pragma("unroll") for (int m = 0; m < 4; ++m) _Pragma("unroll") for (int k = 0; k < 2; ++k) dst[m][k] = *(const PG8_LAS bf16x8*)(lds + PG8_SA(b, h) + aoff + m * 2048 + k * 1024); } while (0)
#define PG8_LDB(dst, b, h) do { _Pragma("unroll") for (int n = 0; n < 2; ++n) _Pragma("unroll") for (int k = 0; k < 2; ++k) dst[n][k] = *(const PG8_LAS bf16x8*)(lds + PG8_SB(b, h) + boff + n * 2048 + k * 1024); } while (0)
#define PG8_MMA(ai, bj, At, Bt) do { __builtin_amdgcn_s_setprio(1); _Pragma("unroll") for (int m = 0; m < 4; ++m) _Pragma("unroll") for (int n = 0; n < 2; ++n) _Pragma("unroll") for (int k = 0; k < 2; ++k) \
        acc[ai][bj][m][n] = __builtin_amdgcn_mfma_f32_16x16x32_bf16(Bt[n][k], At[m][k], acc[ai][bj][m][n], 0, 0, 0); __builtin_amdgcn_s_setprio(0); } while (0)
#define PG8_WAIT_V(n) asm volatile("s_waitcnt vmcnt(" #n ")" ::: "memory")
#define PG8_WAIT_L(n) asm volatile("s_waitcnt lgkmcnt(" #n ")" ::: "memory")
#define PG8_BAR __builtin_amdgcn_s_barrier()
#define PG8_SCHED __builtin_amdgcn_sched_barrier(0)
    Unit cur, nxt; int ui = 0;
    if (!S.next(0, cur)) return;
    const char* cA = (const char*)g.A + (size_t)cur.pm * tstepA; const char* cB = (const char*)g.Bt + (size_t)cur.pn * tstepB;
    S.a_ready(cur);
    if constexpr (SP2) {
        PG8_STAGE(PG8_SB(0, 0), cB, voffB); PG8_STAGE(PG8_SB(0, 1), cB + hstepB, voffB); PG8_STAGE(PG8_SA(0, 0), cA, voffA); PG8_STAGE(PG8_SA(0, 1), cA + hstepA, voffA);
        if (wr == 1) PG8_BAR;
        PG8_WAIT_V(2); PG8_BAR;
        PG8_STAGE(PG8_SB(1, 0), cB + kstep, voffB); PG8_STAGE(PG8_SA(1, 0), cA + kstep, voffA); PG8_STAGE(PG8_SB(1, 1), cB + hstepB + kstep, voffB);
        PG8_WAIT_V(6); PG8_BAR;
    } else {
        PG8_STAGE(PG8_SB(0, 0), cB, voffB); PG8_STAGE(PG8_SA(0, 0), cA, voffA); PG8_STAGE(PG8_SB(0, 1), cB + hstepB, voffB); PG8_STAGE(PG8_SA(0, 1), cA + hstepA, voffA);
        if (wr == 1) PG8_BAR;
        PG8_WAIT_V(4); PG8_BAR;
        PG8_STAGE(PG8_SB(1, 0), cB + kstep, voffB); PG8_STAGE(PG8_SA(1, 0), cA + kstep, voffA); PG8_STAGE(PG8_SB(1, 1), cB + hstepB + kstep, voffB);
        PG8_WAIT_V(6); PG8_BAR;
    }
    f32x4 acc[2][2][4][2];
#pragma unroll
    for (int a = 0; a < 2; ++a)
#pragma unroll
        for (int b = 0; b < 2; ++b)
#pragma unroll
            for (int m = 0; m < 4; ++m)
#pragma unroll
                for (int n = 0; n < 2; ++n) acc[a][b][m][n] = (f32x4){0.f, 0.f, 0.f, 0.f};
    bf16x8 At[4][2], B0[2][2], B1[2][2];
    for (;;) {
        const bool has_next = S.next(ui + 1, nxt);
        const char* nA = has_next ? (const char*)g.A + (size_t)nxt.pm * tstepA : cA; const char* nB = has_next ? (const char*)g.Bt + (size_t)nxt.pn * tstepB : cB;
        for (int t = 0; t < nt; t += 2) {
            const bool last = (t == nt - 2);
            const char* a1 = cA + (size_t)(t + 1) * kstep;
            const char* a2 = last ? nA : cA + (size_t)(t + 2) * kstep; const char* b2 = last ? nB : cB + (size_t)(t + 2) * kstep;
            const char* a3 = a2 + kstep; const char* b3 = b2 + kstep;
            if (last && has_next) S.a_ready(nxt);
            if constexpr (SP2) {
            PG8_LDB(B0, 0, 0); PG8_LDB(B1, 0, 1); PG8_SCHED; PG8_LDA(At, 0, 0); PG8_STAGE(PG8_SA(1, 1), a1 + hstepA, voffA);
            PG8_WAIT_V(8); PG8_WAIT_L(0); PG8_BAR; PG8_MMA(0, 0, At, B0); PG8_MMA(0, 1, At, B1); PG8_BAR; PG8_SCHED;
            PG8_LDA(At, 0, 1); PG8_STAGE(PG8_SB(0, 0), b2, voffB); PG8_STAGE(PG8_SB(0, 1), b2 + hstepB, voffB); PG8_STAGE(PG8_SA(0, 0), a2, voffA);
            PG8_WAIT_V(8); PG8_WAIT_L(0); PG8_BAR; PG8_MMA(1, 0, At, B0); PG8_MMA(1, 1, At, B1); PG8_BAR; PG8_SCHED;
            PG8_LDB(B0, 1, 0); PG8_LDB(B1, 1, 1); PG8_SCHED; PG8_LDA(At, 1, 0); PG8_STAGE(PG8_SA(0, 1), a2 + hstepA, voffA);
            PG8_WAIT_V(8); PG8_WAIT_L(0); PG8_BAR; PG8_MMA(0, 0, At, B0); PG8_MMA(0, 1, At, B1); PG8_BAR; PG8_SCHED;
            PG8_LDA(At, 1, 1); PG8_STAGE(PG8_SB(1, 0), b3, voffB); PG8_STAGE(PG8_SB(1, 1), b3 + hstepB, voffB); PG8_STAGE(PG8_SA(1, 0), a3, voffA);
            PG8_WAIT_V(8); PG8_WAIT_L(0); PG8_BAR; PG8_MMA(1, 0, At, B0); PG8_MMA(1, 1, At, B1); PG8_BAR; PG8_SCHED;
            } else {
            PG8_LDB(B0, 0, 0); PG8_SCHED; PG8_LDA(At, 0, 0); PG8_STAGE(PG8_SA(1, 1), a1 + hstepA, voffA);
            PG8_WAIT_L(8); PG8_BAR; PG8_WAIT_L(0); PG8_MMA(0, 0, At, B0); PG8_BAR; PG8_SCHED;
            PG8_LDB(B1, 0, 1); PG8_STAGE(PG8_SB(0, 0), b2, voffB);
            PG8_BAR; PG8_WAIT_L(0); PG8_MMA(0, 1, At, B1); PG8_BAR;
            PG8_LDA(At, 0, 1); PG8_STAGE(PG8_SA(0, 0), a2, voffA);
            PG8_BAR; PG8_WAIT_L(0); PG8_MMA(1, 0, At, B0); PG8_BAR; PG8_SCHED;
            PG8_STAGE(PG8_SB(0, 1), b2 + hstepB, voffB);
            PG8_WAIT_V(6); PG8_BAR; PG8_MMA(1, 1, At, B1); PG8_BAR;
            PG8_LDB(B0, 1, 0); PG8_SCHED; PG8_LDA(At, 1, 0); PG8_STAGE(PG8_SA(0, 1), a2 + hstepA, voffA);
            PG8_WAIT_L(8); PG8_BAR; PG8_WAIT_L(0); PG8_MMA(0, 0, At, B0); PG8_BAR; PG8_SCHED;
            PG8_LDB(B1, 1, 1); PG8_STAGE(PG8_SB(1, 0), b3, voffB);
            PG8_BAR; PG8_WAIT_L(0); PG8_MMA(0, 1, At, B1); PG8_BAR;
            PG8_LDA(At, 1, 1); PG8_STAGE(PG8_SA(1, 0), a3, voffA);
            PG8_BAR; PG8_WAIT_L(0); PG8_MMA(1, 0, At, B0); PG8_BAR; PG8_SCHED;
            PG8_STAGE(PG8_SB(1, 1), b3 + hstepB, voffB);
            PG8_WAIT_V(6); PG8_BAR; PG8_MMA(1, 1, At, B1); PG8_BAR;
            }
        }
        if constexpr (ALIGN_EPI) { if (wr == 0) PG8_BAR; }
        if constexpr (!Epi::AFTER_DRAIN) { E(acc, cur, wr, wc, fr, fq); S.done(cur); }
        if (!has_next) break;
#pragma unroll
        for (int a = 0; a < 2; ++a)
#pragma unroll
            for (int b = 0; b < 2; ++b)
#pragma unroll
                for (int m = 0; m < 4; ++m)
#pragma unroll
                    for (int n = 0; n < 2; ++n) acc[a][b][m][n] = (f32x4){0.f, 0.f, 0.f, 0.f};
        cur = nxt; cA = nA; cB = nB; ++ui;
        if constexpr (ALIGN_EPI) { if (wr == 1) PG8_BAR; }
    }
    PG8_WAIT_V(0);
    if constexpr (!ALIGN_EPI) { if (wr == 0) PG8_BAR; }
    PG8_BAR;
    if constexpr (Epi::AFTER_DRAIN) { E.fused(acc, cur, wr, wc, fr, fq, lds, wid, lane); S.done(cur); }
#undef PG8_SA
#undef PG8_SB
#undef PG8_STAGE
#undef PG8_LDA
#undef PG8_LDB
#undef PG8_MMA
#undef PG8_WAIT_V
#undef PG8_WAIT_L
#undef PG8_BAR
#undef PG8_SCHED
}
}

#define GAS __attribute__((address_space(1)))
#define LAS __attribute__((address_space(3)))
typedef unsigned short bf16_t;
typedef short bf16x8 __attribute__((ext_vector_type(8)));
typedef float f32x4 __attribute__((ext_vector_type(4)));
typedef unsigned u32x4 __attribute__((ext_vector_type(4)));
typedef unsigned u32x2 __attribute__((ext_vector_type(2)));
typedef GAS unsigned long long gu64;
#define RLX_AGENT __ATOMIC_RELAXED, __HIP_MEMORY_SCOPE_AGENT

constexpr int D = 1024, DIN = 4096, SEQ = 2048, NBP = 8, MP = NBP * SEQ, NBS = 128, TS = 8, MS = NBS * TS, MT = MP + MS, DEPTH = 4;
constexpr int ZV = 0, ZU = 1024, ZGP = 2048, ZGL = 3072;
constexpr int NCHUNK = SEQ / 128;
constexpr float EPS = 1e-6f, LOG2E = 1.4426950408889634f;
constexpr unsigned CTAG = 0x5A17C0DEu;

constexpr size_t MiB = 1u << 20;
constexpr size_t WS_CARRY = 0;
constexpr size_t WS_WIN = 4 * MiB;
constexpr size_t WS_WOUT = 36 * MiB;
constexpr size_t WS_POOLW = 52 * MiB;
constexpr size_t WS_WA = 54 * MiB, WS_WX = 55 * MiB;
constexpr size_t WS_XN = 56 * MiB;
constexpr size_t WS_Z = 90 * MiB;
constexpr size_t WS_END = WS_Z + (size_t)MT * DIN * 2;
constexpr size_t WS_LC = 235 * MiB;
constexpr size_t WS_PART = 228 * MiB;
constexpr size_t WS_RINV = 236 * MiB;
constexpr size_t WS_Q = 239 * MiB;
constexpr size_t WS_BAR = 240 * MiB;
static_assert(WS_XN + (size_t)MT * D * 2 <= WS_Z && WS_END <= WS_BAR, "ws map");

constexpr size_t O_YP = 0, O_YS = (size_t)MP * D, O_PP = O_YS + (size_t)MS * D, O_CP = O_PP + (size_t)DEPTH * NBP * 15 * 1024,
                 O_LP = O_CP + (size_t)DEPTH * NBP * 3 * 1024, O_PS = O_LP + (size_t)DEPTH * NBP * 1024, O_CS = O_PS + (size_t)DEPTH * NBS * 15 * 1024,
                 O_LS = O_CS + (size_t)DEPTH * NBS * 3 * 1024, O_END = O_LS + (size_t)DEPTH * NBS * 1024;

constexpr int LDS_BYTES = 131072 + 4096;
constexpr int NTHREADS = 512, NWAVES = 8;

struct Params {
    const float* xp; const float* xs; const float* st_pool; const float* st_conv; const float* st_lru; const float* norm_pre; const float* norm_post; const float* w_in;
    const float* pool_w; const float* pool_scale; const float* conv_w; const float* conv_b; const float* lru_wa; const float* lru_ba; const float* lru_wx; const float* lru_bx;
    const float* lru_lam; const float* w_out; float* out; unsigned char* ws;
};

__device__ __forceinline__ float bf2f(unsigned b) { return __uint_as_float(b << 16); }
__device__ __forceinline__ unsigned pkbf(float lo, float hi) { return pg8::cvt_pk_bf16(lo, hi); }
__device__ __forceinline__ int fresh_lane() { int l; asm volatile("v_mbcnt_lo_u32_b32 %0, -1, 0\n\tv_mbcnt_hi_u32_b32 %0, -1, %0" : "=v"(l)); return l; }
__device__ __forceinline__ float shfl_lane(float v, int src) { return __int_as_float(__builtin_amdgcn_ds_bpermute(src << 2, __float_as_int(v))); }
__device__ __forceinline__ float wave_sum(float v, int lane) {
#pragma unroll
    for (int o = 1; o < 64; o <<= 1) v += shfl_lane(v, lane ^ o);
    return v;
}
__device__ __forceinline__ void unpack8(const u32x4 w, float (&v)[8]) {
    v[0] = __uint_as_float(w.x << 16); v[1] = __uint_as_float(w.x & 0xffff0000u); v[2] = __uint_as_float(w.y << 16); v[3] = __uint_as_float(w.y & 0xffff0000u);
    v[4] = __uint_as_float(w.z << 16); v[5] = __uint_as_float(w.z & 0xffff0000u); v[6] = __uint_as_float(w.w << 16); v[7] = __uint_as_float(w.w & 0xffff0000u);
}
__device__ __forceinline__ void ldbf8(const bf16_t* p, float (&v)[8]) { unpack8(*(const u32x4*)p, v); }
__device__ __forceinline__ void ldf8(const float* p, float (&v)[8]) { const f32x4 a = *(const f32x4*)p, b = *(const f32x4*)(p + 4); v[0] = a.x; v[1] = a.y; v[2] = a.z; v[3] = a.w; v[4] = b.x; v[5] = b.y; v[6] = b.z; v[7] = b.w; }
__device__ __forceinline__ u32x4 pack8(const float (&v)[8]) { u32x4 o; o.x = pkbf(v[0], v[1]); o.y = pkbf(v[2], v[3]); o.z = pkbf(v[4], v[5]); o.w = pkbf(v[6], v[7]); return o; }
__device__ __forceinline__ float sigm(float x) { return __builtin_amdgcn_rcpf(1.0f + __builtin_amdgcn_exp2f(-LOG2E * x)); }
__device__ __forceinline__ float silu(float x) { return x * sigm(x); }
__device__ __forceinline__ f32x4 silu4(const f32x4 g) {
    const f32x4 t = g * (-LOG2E);
    const f32x4 d = (f32x4){__builtin_amdgcn_exp2f(t[0]), __builtin_amdgcn_exp2f(t[1]), __builtin_amdgcn_exp2f(t[2]), __builtin_amdgcn_exp2f(t[3])} + 1.0f;
    return g * (f32x4){__builtin_amdgcn_rcpf(d[0]), __builtin_amdgcn_rcpf(d[1]), __builtin_amdgcn_rcpf(d[2]), __builtin_amdgcn_rcpf(d[3])};
}

__device__ __forceinline__ void transpose_item(const float* src, int ld_src, bf16_t* dst, int ld_dst, int k0, int n0s, int n0d, const float* kscale, const float* nscale, float mul, LAS float* scr, int lane) {
    float tv[32];
#pragma unroll
    for (int i = 0; i < 32; ++i) tv[i] = src[(size_t)(k0 + 2 * i + (lane >> 5)) * ld_src + n0s + (lane & 31)];
#pragma unroll
    for (int i = 0; i < 32; ++i) { const int kk = 2 * i + (lane >> 5); float v = tv[i]; if (kscale) v *= kscale[k0 + kk]; scr[kk * 33 + (lane & 31)] = v; }
    asm volatile("s_waitcnt lgkmcnt(0)" ::: "memory");
    const int c = lane & 7;
#pragma unroll
    for (int j = 0; j < 4; ++j) { const int n = (lane >> 3) + 8 * j; const LAS float* s = scr + (8 * c) * 33 + n; const float ns = (nscale ? nscale[n0s + n] : 1.0f) * mul;
        u32x4 o; o.x = pkbf(s[0 * 33] * ns, s[1 * 33] * ns); o.y = pkbf(s[2 * 33] * ns, s[3 * 33] * ns); o.z = pkbf(s[4 * 33] * ns, s[5 * 33] * ns); o.w = pkbf(s[6 * 33] * ns, s[7 * 33] * ns);
        *(u32x4*)(dst + (size_t)(n0d + n) * ld_dst + k0 + 8 * c) = o; }
    asm volatile("s_waitcnt lgkmcnt(0)" ::: "memory");
}
__device__ __forceinline__ const float* xrow_in(const Params& p, int row) { return row < MP ? p.xp + (size_t)row * D : p.xs + (size_t)(row - MP) * D; }

__device__ __forceinline__ void p0_phase(const Params& p, LAS unsigned char* lds, int gw, int NGW, int wid, int lane) {
    LAS float* scr = (LAS float*)(lds + wid * 8704);
    unsigned char* ws = p.ws;
    constexpr int I_IN = 16 * 128, I_OUT = 32 * 32, I_POOL = 4 * 4 * 8, I_G = 8 * 2 * 4, I_LAYER = I_IN + I_OUT + I_POOL + 2 * I_G;
    for (int it = gw; it < DEPTH * I_LAYER; it += NGW) {
        const int l = it / I_LAYER; int r = it % I_LAYER;
        if (r < I_IN) { const int kb = r / 128, nb = r % 128, n0s = nb * 32, blk = n0s >> 10, dblk = (blk == 1) ? 2 : (blk == 2 ? 1 : blk);
            transpose_item(p.w_in + (size_t)l * D * DIN, DIN, (bf16_t*)(ws + WS_WIN) + (size_t)l * DIN * D, D, kb * 64, n0s, dblk * 1024 + (n0s & 1023), p.norm_pre + l * D, nullptr, 1.0f, scr, lane); continue; }
        r -= I_IN;
        if (r < I_OUT) { const int kb = r / 32, nb = r % 32;
            transpose_item(p.w_out + (size_t)l * 2048 * D, D, (bf16_t*)(ws + WS_WOUT) + (size_t)l * D * 2048, 2048, kb * 64, nb * 32, nb * 32, nullptr, nullptr, 1.0f, scr, lane); continue; }
        r -= I_OUT;
        if (r < I_POOL) { const int g = r / 32, q = r % 32, kb = q / 8, nb = q % 8;
            transpose_item(p.pool_w + (size_t)(l * 4 + g) * 65536, 256, (bf16_t*)(ws + WS_POOLW) + (size_t)(l * 4 + g) * 65536, 256, kb * 64, nb * 32, nb * 32, nullptr, p.pool_scale + l * 1024 + g * 256, 1.0f, scr, lane); continue; }
        r -= I_POOL;
        { const bool isx = r >= I_G; if (isx) r -= I_G; const int h = r / 8, q = r % 8, kb = q / 4, nb = q % 4;
            transpose_item((isx ? p.lru_wx : p.lru_wa) + (size_t)(l * 8 + h) * 16384, 128, (bf16_t*)(ws + (isx ? WS_WX : WS_WA)) + (size_t)(l * 8 + h) * 16384, 128, kb * 64, nb * 32, nb * 32, nullptr, nullptr, -LOG2E, scr, lane); }
    }
    float* RINV = (float*)(ws + WS_RINV);
    bf16_t* XN = (bf16_t*)(ws + WS_XN);
    for (int row0 = 2 * gw; row0 < MT; row0 += 2 * NGW) {
        float v[2][2][8]; float ss[2] = {0.f, 0.f};
#pragma unroll
        for (int r = 0; r < 2; ++r) { const float* x = xrow_in(p, row0 + r);
#pragma unroll
            for (int j = 0; j < 2; ++j) ldf8(x + j * 512 + lane * 8, v[r][j]); }
#pragma unroll
        for (int r = 0; r < 2; ++r) {
#pragma unroll
            for (int j = 0; j < 2; ++j)
#pragma unroll
                for (int e = 0; e < 8; ++e) ss[r] += v[r][j][e] * v[r][j][e];
            const float rinv = __builtin_amdgcn_rsqf(wave_sum(ss[r], lane) * (1.0f / D) + EPS);
            if (lane == 0) RINV[row0 + r] = rinv;
#pragma unroll
            for (int j = 0; j < 2; ++j) *(u32x4*)(XN + (size_t)(row0 + r) * D + j * 512 + lane * 8) = pack8(v[r][j]); }
    }
    { float* LC = (float*)(ws + WS_LC);
      for (int i = gw * 64 + lane; i < DEPTH * 1024; i += NGW * 64) { const int l = i >> 10, c = i & 1023;
          LC[(l * 3 + 0) * 1024 + c] = -LOG2E * p.lru_ba[i]; LC[(l * 3 + 1) * 1024 + c] = -LOG2E * p.lru_bx[i]; LC[(l * 3 + 2) * 1024 + c] = -8.0f * LOG2E * log1pf(expf(-p.lru_lam[i])); } }
    gu64* carry = (gu64*)(ws + WS_CARRY);
    for (int i = gw * 64 + lane; i < DEPTH * NBP * NCHUNK * 1024; i += NGW * 64) __hip_atomic_store(carry + i, 0ull, RLX_AGENT);
}

template <int NP> __device__ __forceinline__ void f_phase(const Params& p, int l, int row_lo, int row_hi, int gw, int NGW, int lane) {
    bf16_t* X16 = (bf16_t*)(p.ws + WS_XN); const bf16_t* Z = (const bf16_t*)(p.ws + WS_Z); float* RINV = (float*)(p.ws + WS_RINV);
    const float* gpost = p.norm_post + l * D;
    float gp[2][8];
#pragma unroll
    for (int j = 0; j < 2; ++j) ldf8(gpost + j * 512 + lane * 8, gp[j]);
    for (int row0 = row_lo + 2 * gw; row0 < row_hi; row0 += 2 * NGW) {
        float o[2][2][8], v[2][2][8]; float so[2] = {0.f, 0.f}, sn[2] = {0.f, 0.f};
#pragma unroll
        for (int r = 0; r < 2; ++r) { const int row = row0 + r;
#pragma unroll
            for (int j = 0; j < 2; ++j) { ldbf8(Z + (size_t)row * DIN + ZV + j * 512 + lane * 8, o[r][j]); ldbf8(X16 + (size_t)row * D + j * 512 + lane * 8, v[r][j]);
                if (NP > 1) { float o2[8]; ldbf8(Z + (size_t)row * DIN + ZU + j * 512 + lane * 8, o2);
#pragma unroll
                    for (int e = 0; e < 8; ++e) o[r][j][e] += o2[e]; }
                if (NP > 2) {
#pragma unroll
                    for (int k = 0; k < NP - 2; ++k) { float o2[8]; ldbf8((const bf16_t*)(p.ws + WS_PART) + ((size_t)k * MS + (row - MP)) * D + j * 512 + lane * 8, o2);
#pragma unroll
                        for (int e = 0; e < 8; ++e) o[r][j][e] += o2[e]; } }
            } }
#pragma unroll
        for (int r = 0; r < 2; ++r)
#pragma unroll
            for (int j = 0; j < 2; ++j)
#pragma unroll
                for (int e = 0; e < 8; ++e) so[r] += o[r][j][e] * o[r][j][e];
#pragma unroll
        for (int r = 0; r < 2; ++r) { const int row = row0 + r;
            const float rn = __builtin_amdgcn_rsqf(wave_sum(so[r], lane) * (1.0f / D) + EPS);
#pragma unroll
            for (int j = 0; j < 2; ++j)
#pragma unroll
                for (int e = 0; e < 8; ++e) { v[r][j][e] = v[r][j][e] + o[r][j][e] * rn * gp[j][e]; sn[r] += v[r][j][e] * v[r][j][e]; }
            if (l < DEPTH - 1) {
                const float rinv = __builtin_amdgcn_rsqf(wave_sum(sn[r], lane) * (1.0f / D) + EPS);
                if (lane == 0) RINV[row] = rinv;
#pragma unroll
                for (int j = 0; j < 2; ++j) *(u32x4*)(X16 + (size_t)row * D + j * 512 + lane * 8) = pack8(v[r][j]);
            } else {
                float* y = p.out + (size_t)row * D;
#pragma unroll
                for (int j = 0; j < 2; ++j) { *(f32x4*)(y + j * 512 + lane * 8) = (f32x4){v[r][j][0], v[r][j][1], v[r][j][2], v[r][j][3]}; *(f32x4*)(y + j * 512 + lane * 8 + 4) = (f32x4){v[r][j][4], v[r][j][5], v[r][j][6], v[r][j][7]}; }
            }
        }
    }
}

constexpr int PA = 264, LA = 136;

template <bool SAMPLE, int G> __device__ __forceinline__ void pool_build_d(const Params& p, int l, int r0, LAS bf16_t* At, int tid) {
    constexpr int W = 2 << G, R = W + 7;
    const bf16_t* Z = (const bf16_t*)(p.ws + WS_Z);
    const int c8 = tid & 31, rseg = tid >> 5, ch = G * 256 + c8 * 8;
    const bf16_t* zseq; const float* st = nullptr; int j0;
    if (SAMPLE) { const int s = (r0 - MP) / TS + rseg; zseq = Z + (size_t)(MP + s * TS) * DIN + ZV + ch; st = p.st_pool + ((size_t)l * NBS + s) * 15 * 1024 + ch; j0 = 0; }
    else { const int b = r0 / SEQ; zseq = Z + (size_t)b * SEQ * DIN + ZV + ch; j0 = (r0 % SEQ) + rseg * 8; }
    u32x4 rows[R];
#pragma unroll
    for (int rr = 0; rr < R; ++rr) {
        const int j = j0 - (W - 1) + rr;
        if (SAMPLE) { if (rr >= W - 1) rows[rr] = *(const u32x4*)(zseq + (size_t)j * DIN); else { float t[8]; ldf8(st + (15 + j) * 1024, t); rows[rr] = pack8(t); } }
        else { rows[rr] = *(const u32x4*)(zseq + (size_t)(j < 0 ? 0 : j) * DIN); if (j < 0) rows[rr] = (u32x4){0u, 0u, 0u, 0u}; }
    }
    if (R == 9) asm volatile("" : "+v"(rows[0]), "+v"(rows[1]), "+v"(rows[2]), "+v"(rows[3]), "+v"(rows[4]), "+v"(rows[5]), "+v"(rows[6]), "+v"(rows[7]), "+v"(rows[8]));
    if (R >= 11) asm volatile("" : "+v"(rows[0]), "+v"(rows[1]), "+v"(rows[2]), "+v"(rows[3]), "+v"(rows[4]), "+v"(rows[5]), "+v"(rows[6]), "+v"(rows[7]), "+v"(rows[8]), "+v"(rows[9]), "+v"(rows[10]));
    if (R >= 15) asm volatile("" : "+v"(rows[(R >= 15) ? 11 : 0]), "+v"(rows[(R >= 15) ? 12 : 0]), "+v"(rows[(R >= 15) ? 13 : 0]), "+v"(rows[(R >= 15) ? 14 : 0]));
    if (R >= 23) asm volatile("" : "+v"(rows[(R >= 23) ? 15 : 0]), "+v"(rows[(R >= 23) ? 16 : 0]), "+v"(rows[(R >= 23) ? 17 : 0]), "+v"(rows[(R >= 23) ? 18 : 0]), "+v"(rows[(R >= 23) ? 19 : 0]), "+v"(rows[(R >= 23) ? 20 : 0]), "+v"(rows[(R >= 23) ? 21 : 0]), "+v"(rows[(R >= 23) ? 22 : 0]));
    float S[8];
#pragma unroll
    for (int e = 0; e < 8; ++e) S[e] = 0.f;
#pragma unroll
    for (int rr = 0; rr < R; ++rr) {
        float v[8]; unpack8(rows[rr], v);
#pragma unroll
        for (int e = 0; e < 8; ++e) S[e] += v[e];
        if (rr >= W - 1) {
            const int i = rr - (W - 1), j = j0 + i;
            const float rc = SAMPLE ? 1.0f / (float)W : __builtin_amdgcn_rcpf((float)min(j + 1, W));
            float dd[8], o[8];
#pragma unroll
            for (int e = 0; e < 8; ++e) dd[e] = S[e] * rc - v[e];
            *(LAS u32x4*)(At + (rseg * 8 + i) * PA + c8 * 8) = pack8(dd);
            unpack8(rows[rr - W + 1], o);
#pragma unroll
            for (int e = 0; e < 8; ++e) S[e] -= o[e];
        }
    }
}
template <bool SAMPLE> __device__ __forceinline__ void pool_job(const Params& p, int l, int r0, int g, LAS unsigned char* lds, const int wid) {
    bf16_t* Z = (bf16_t*)(p.ws + WS_Z);
    LAS bf16_t* At = (LAS bf16_t*)lds;
    bf16x8 bfr[8][2];
    {
        const int lane0 = fresh_lane(), r16 = lane0 & 15, q = lane0 >> 4;
        const bf16_t* Bw = (const bf16_t*)(p.ws + WS_POOLW) + ((size_t)(l * 4 + g) * 256 + wid * 32 + r16) * 256 + q * 8;
#pragma unroll
        for (int ks = 0; ks < 8; ++ks) { bfr[ks][0] = *(const bf16x8*)(Bw + ks * 32); bfr[ks][1] = *(const bf16x8*)(Bw + 16 * 256 + ks * 32); }
    }
    { const int tid = wid * 64 + fresh_lane();
    if (g == 0) pool_build_d<SAMPLE, 0>(p, l, r0, At, tid); else if (g == 1) pool_build_d<SAMPLE, 1>(p, l, r0, At, tid);
    else if (g == 2) pool_build_d<SAMPLE, 2>(p, l, r0, At, tid); else pool_build_d<SAMPLE, 3>(p, l, r0, At, tid); }
    __syncthreads();
    const int lane = fresh_lane(), r16 = lane & 15, q = lane >> 4;
    f32x4 acc[8][2];
#pragma unroll
    for (int m = 0; m < 8; ++m) { acc[m][0] = (f32x4){0.f, 0.f, 0.f, 0.f}; acc[m][1] = (f32x4){0.f, 0.f, 0.f, 0.f}; }
    const unsigned poff = (unsigned)(((r0 + r16) * DIN + ZGP + g * 256 + wid * 32 + q * 4) * 2);
    u32x2 gv[8][2];
#pragma unroll
    for (int m = 0; m < 8; ++m)
#pragma unroll
        for (int nb = 0; nb < 2; ++nb) gv[m][nb] = *(const u32x2*)((const char*)Z + (poff + (unsigned)(m * 16 * DIN * 2 + nb * 32)));
    f32x4 sv[8][2];
#pragma unroll
    for (int ks = 0; ks < 8; ++ks) {
        const bf16x8 b0 = bfr[ks][0], b1 = bfr[ks][1];
#pragma unroll
        for (int m = 0; m < 8; ++m) { const bf16x8 a = *(const LAS bf16x8*)(At + (m * 16 + r16) * PA + ks * 32 + q * 8);
            acc[m][0] = __builtin_amdgcn_mfma_f32_16x16x32_bf16(b0, a, acc[m][0], 0, 0, 0); acc[m][1] = __builtin_amdgcn_mfma_f32_16x16x32_bf16(b1, a, acc[m][1], 0, 0, 0); }
#pragma unroll
        for (int nb = 0; nb < 2; ++nb) { const u32x2 gw2 = gv[ks][nb];
            sv[ks][nb] = silu4((f32x4){__uint_as_float(gw2.x << 16), __uint_as_float(gw2.x & 0xffff0000u), __uint_as_float(gw2.y << 16), __uint_as_float(gw2.y & 0xffff0000u)}); }
    }
#pragma unroll
    for (int m = 0; m < 8; ++m)
#pragma unroll
        for (int nb = 0; nb < 2; ++nb) {
            bf16_t* zp = (bf16_t*)((char*)Z + (poff + (unsigned)(m * 16 * DIN * 2 + nb * 32)));
            const f32x4 yv = acc[m][nb] * sv[m][nb];
            u32x2 o; o.x = pkbf(yv[0], yv[1]); o.y = pkbf(yv[2], yv[3]);
            *(u32x2*)zp = o;
        }
    __syncthreads();
}

template <bool SAMPLE> __device__ __forceinline__ void conv_getrow(float (&v)[8], const bf16_t* zseq, const float* st, int j, int ch) {
    if (SAMPLE) { if (j >= 0) ldbf8(zseq + (size_t)j * DIN + ZU + ch, v); else ldf8(st + (3 + j) * 1024 + ch, v); }
    else {
        u32x4 w = *(const u32x4*)(zseq + (size_t)(j < 0 ? 0 : j) * DIN + ZU + ch);
        if (j < 0) w = (u32x4){0u, 0u, 0u, 0u};
        unpack8(w, v); }
}
__device__ __forceinline__ float chain_wait(gu64* slot) {
    unsigned long long x; unsigned spins = 0;
    for (;;) { x = __hip_atomic_load(slot, RLX_AGENT); if ((unsigned)(x >> 32) == CTAG) break; __builtin_amdgcn_s_sleep(2); if (++spins > (1u << 18)) { x = 0x7fc00000ull; break; } }
    return __uint_as_float((unsigned)x);
}
template <bool SAMPLE> __device__ __forceinline__ void lru_job(const Params& p, int l, int r0, int h, LAS unsigned char* lds, const int wid) {
    bf16_t* Z = (bf16_t*)(p.ws + WS_Z);
    LAS bf16_t* At = (LAS bf16_t*)lds;
    const int lane = fresh_lane(), tid = wid * 64 + lane;
    const int c = h * 128 + wid * 16 + (lane & 15);
    const float* LC = (const float*)(p.ws + WS_LC) + (size_t)l * 3 * 1024 + c;
    const float bav = LC[0], bxv = LC[1024], cl2 = LC[2048];
    bf16x8 wfa[4], wfx[4];
    {
        const bf16_t* Wa = (const bf16_t*)(p.ws + WS_WA) + ((size_t)(l * 8 + h) * 128 + wid * 16 + (lane & 15)) * 128 + (lane >> 4) * 8;
        const bf16_t* Wx = (const bf16_t*)(p.ws + WS_WX) + ((size_t)(l * 8 + h) * 128 + wid * 16 + (lane & 15)) * 128 + (lane >> 4) * 8;
#pragma unroll
        for (int ks = 0; ks < 4; ++ks) { wfa[ks] = *(const bf16x8*)(Wa + ks * 32); wfx[ks] = *(const bf16x8*)(Wx + ks * 32); }
    }
    {
        const int c8 = tid & 15, rseg = tid >> 4, ch = h * 128 + c8 * 8;
        const bf16_t* zseq; const float* st = nullptr; int j0;
        if (SAMPLE) { const int s = (r0 - MP) / TS + (rseg >> 1); zseq = Z + (size_t)(MP + s * TS) * DIN; st = p.st_conv + ((size_t)l * NBS + s) * 3 * 1024; j0 = (rseg & 1) * 4; }
        else { const int b = r0 / SEQ; zseq = Z + (size_t)b * SEQ * DIN; j0 = (r0 % SEQ) + rseg * 4; }
        float cw[4][8], y[4][8], u[8];
#pragma unroll
        for (int k = 0; k < 4; ++k) ldf8(p.conv_w + ((size_t)l * 4 + k) * 1024 + ch, cw[k]);
        ldf8(p.conv_b + (size_t)l * 1024 + ch, u);
#pragma unroll
        for (int i = 0; i < 4; ++i)
#pragma unroll
            for (int e = 0; e < 8; ++e) y[i][e] = u[e];
        u32x4 rw[7];
        if (!SAMPLE) {
#pragma unroll
            for (int e7 = 0; e7 < 7; ++e7) { const int j = j0 - 3 + e7; rw[e7] = *(const u32x4*)(zseq + (size_t)(j < 0 ? 0 : j) * DIN + ZU + ch); }
            asm volatile("" : "+v"(rw[0]), "+v"(rw[1]), "+v"(rw[2]), "+v"(rw[3]), "+v"(rw[4]), "+v"(rw[5]), "+v"(rw[6]));
        }
#pragma unroll
        for (int e7 = 0; e7 < 7; ++e7) {
            if (SAMPLE) conv_getrow<SAMPLE>(u, zseq, st, j0 - 3 + e7, ch);
            else { u32x4 w = rw[e7]; if (j0 - 3 + e7 < 0) w = (u32x4){0u, 0u, 0u, 0u}; unpack8(w, u); }
#pragma unroll
            for (int i = 0; i < 4; ++i) { const int k = e7 - i; if (k >= 0 && k < 4) {
#pragma unroll
                for (int e = 0; e < 8; ++e) y[i][e] += u[e] * cw[k][e]; } }
        }
#pragma unroll
        for (int i = 0; i < 4; ++i) *(LAS u32x4*)(At + (rseg * 4 + i) * LA + c8 * 8) = pack8(y[i]);
    }
    __syncthreads();
    const int r16 = lane & 15, q = lane >> 4;
    f32x4 aa[8], ax[8];
#pragma unroll
    for (int m = 0; m < 8; ++m) { aa[m] = (f32x4){0.f, 0.f, 0.f, 0.f}; ax[m] = (f32x4){0.f, 0.f, 0.f, 0.f}; }
    {
#pragma unroll
        for (int ks = 0; ks < 4; ++ks) {
            const bf16x8 ba = wfa[ks], bx = wfx[ks];
#pragma unroll
            for (int m = 0; m < 8; ++m) { const bf16x8 a = *(const LAS bf16x8*)(At + (m * 16 + r16) * LA + ks * 32 + q * 8);
                aa[m] = __builtin_amdgcn_mfma_f32_16x16x32_bf16(a, ba, aa[m], 0, 0, 0); ax[m] = __builtin_amdgcn_mfma_f32_16x16x32_bf16(a, bx, ax[m], 0, 0, 0); }
        }
    }
    const int t0 = SAMPLE ? 1 : (r0 % SEQ);
    typedef float f32x2 __attribute__((ext_vector_type(2)));
#pragma unroll
    for (int m = 0; m < 8; ++m)
#pragma unroll
        for (int ip = 0; ip < 4; ip += 2) {
            const int rl = m * 16 + q * 4 + ip;
            const f32x2 xs = {bf2f((unsigned)At[rl * LA + wid * 16 + r16]), bf2f((unsigned)At[(rl + 1) * LA + wid * 16 + r16])};
            const f32x2 za = (f32x2){aa[m][ip], aa[m][ip + 1]} + bav, zx = (f32x2){ax[m][ip], ax[m][ip + 1]} + bxv;
            const f32x2 da = (f32x2){__builtin_amdgcn_exp2f(za.x), __builtin_amdgcn_exp2f(za.y)} + 1.0f, dx = (f32x2){__builtin_amdgcn_exp2f(zx.x), __builtin_amdgcn_exp2f(zx.y)} + 1.0f;
            const f32x2 r = {__builtin_amdgcn_rcpf(da.x), __builtin_amdgcn_rcpf(da.y)}, gi = {__builtin_amdgcn_rcpf(dx.x), __builtin_amdgcn_rcpf(dx.y)};
            const f32x2 la = r * cl2;
            const f32x2 a = {__builtin_amdgcn_exp2f(la.x), __builtin_amdgcn_exp2f(la.y)};
            const f32x2 om = (f32x2){1.0f, 1.0f} - a * a;
            f32x2 mult = {__builtin_amdgcn_sqrtf(fmaxf(om.x, 1e-12f)), __builtin_amdgcn_sqrtf(fmaxf(om.y, 1e-12f))};
            if (!SAMPLE && m == 0 && ip == 0) { if (t0 + rl == 0) mult.x = 1.0f; }
            const f32x2 u = xs * gi * mult;
            aa[m][ip] = a.x; aa[m][ip + 1] = a.y; ax[m][ip] = u.x; ax[m][ip + 1] = u.y;
        }
    asm volatile("" ::: "memory");
    const unsigned goff = (unsigned)(((r0 + q * 4) * DIN + ZGL + c) * 2);
    unsigned short glv[8][4];
#pragma unroll
    for (int m = 0; m < 8; ++m)
#pragma unroll
        for (int i = 0; i < 4; ++i) glv[m][i] = *(const unsigned short*)((const char*)Z + (goff + (unsigned)((m * 16 + i) * DIN * 2)));
    float* outp = p.out;
    if (SAMPLE) {
        const int s0 = (r0 - MP) / TS;
#pragma unroll
        for (int m = 0; m < 8; ++m) {
            float P = 1.f, H = 0.f;
#pragma unroll
            for (int i = 0; i < 4; ++i) { H = aa[m][i] * H + ax[m][i]; P *= aa[m][i]; ax[m][i] = H; aa[m][i] = P; }
            const float P1 = shfl_lane(P, (lane - 16) & 63), H1 = shfl_lane(H, (lane - 16) & 63);
            const int s = s0 + m * 2 + (q >> 1);
            const float h0 = p.st_lru[((size_t)l * NBS + s) * 1024 + c];
            const float QH = (q & 1) ? (P1 * h0 + H1) : h0;
#pragma unroll
            for (int i = 0; i < 4; i += 4) ax[m] = aa[m] * QH + ax[m];
            if (q & 1) outp[O_LS + ((size_t)l * NBS + s) * 1024 + c] = ax[m][3];
        }
    } else {
        float cP = 1.f, cH = 0.f;
#pragma unroll
        for (int m = 0; m < 8; ++m) {
            float P = 1.f, H = 0.f;
#pragma unroll
            for (int i = 0; i < 4; ++i) { H = aa[m][i] * H + ax[m][i]; P *= aa[m][i]; ax[m][i] = H; aa[m][i] = P; }
            float EP = 1.f, EH = 0.f;
#pragma unroll
            for (int d = 3; d >= 1; --d) { const float Pd = shfl_lane(P, (lane - 16 * d) & 63), Hd = shfl_lane(H, (lane - 16 * d) & 63); if (q >= d) { EH = Pd * EH + Hd; EP = Pd * EP; } }
            float TP = P * EP, TH = P * EH + H;
            TP = shfl_lane(TP, 48 + r16); TH = shfl_lane(TH, 48 + r16);
            const float QH = EP * cH + EH, QP = EP * cP;
#pragma unroll
            for (int i = 0; i < 4; i += 4) { ax[m] = aa[m] * QH + ax[m]; aa[m] = aa[m] * QP; }
            cH = TP * cH + TH; cP = TP * cP;
        }
        const int b = r0 / SEQ, tch = (r0 % SEQ) / 128;
        gu64* agg = (gu64*)(p.ws + WS_CARRY) + (((size_t)l * NBP + b) * NCHUNK) * 1024 + c;
        if (q == 0 && tch < NCHUNK - 1) __hip_atomic_store(agg + (size_t)tch * 1024, ((unsigned long long)__float_as_uint(cP) << 32) | (unsigned long long)__float_as_uint(cH), RLX_AGENT);
        float h_in = 0.f;
        if (tch > 0) {
            unsigned long long x[NCHUNK - 1];
            for (unsigned spins = 0;;) {
                bool ok = true;
#pragma unroll
                for (int k = 0; k < NCHUNK - 1; ++k) if (k < tch) { x[k] = __hip_atomic_load(agg + (size_t)k * 1024, RLX_AGENT); ok = ok && ((unsigned)(x[k] >> 32) != 0u); }
                if (__all(ok)) break;
                __builtin_amdgcn_s_sleep(2);
                if (++spins > (1u << 18)) break;
            }
#pragma unroll
            for (int k = 0; k < NCHUNK - 1; ++k) if (k < tch) h_in = __uint_as_float((unsigned)(x[k] >> 32)) * h_in + __uint_as_float((unsigned)x[k]);
        }
        if (q == 0 && tch == NCHUNK - 1) outp[O_LP + ((size_t)l * NBP + b) * 1024 + c] = cP * h_in + cH;
#pragma unroll
        for (int m = 0; m < 8; ++m)
#pragma unroll
            for (int i = 0; i < 4; i += 4) ax[m] = aa[m] * h_in + ax[m];
    }
#pragma unroll
    for (int m = 0; m < 8; ++m) {
        const f32x4 yv = ax[m] * silu4((f32x4){bf2f((unsigned)glv[m][0]), bf2f((unsigned)glv[m][1]), bf2f((unsigned)glv[m][2]), bf2f((unsigned)glv[m][3])});
        const unsigned w01 = pkbf(yv[0], yv[1]), w23 = pkbf(yv[2], yv[3]);
        *(bf16_t*)((char*)Z + (goff + (unsigned)((m * 16 + 0) * DIN * 2))) = (bf16_t)(w01 & 0xffffu);
        *(bf16_t*)((char*)Z + (goff + (unsigned)((m * 16 + 1) * DIN * 2))) = (bf16_t)(w01 >> 16);
        *(bf16_t*)((char*)Z + (goff + (unsigned)((m * 16 + 2) * DIN * 2))) = (bf16_t)(w23 & 0xffffu);
        *(bf16_t*)((char*)Z + (goff + (unsigned)((m * 16 + 3) * DIN * 2))) = (bf16_t)(w23 >> 16);
    }
    __syncthreads();
}

#ifndef G_ALIGN
#define G_ALIGN true
#endif
#ifndef G_SP2
#define G_SP2 true
#endif
struct EpiStore {
    static constexpr bool PERM = true, AFTER_DRAIN = false;
    bf16_t* O; int ldc; const float* rscale;
    __device__ __forceinline__ void operator()(const f32x4 (&acc)[2][2][4][2], const pg8::Unit& u, int wr, int wc, int fr, int fq) const {
        const int row0 = u.pm * pg8::BM + wr * 64 + fr;
        const __amdgpu_buffer_rsrc_t rs = __builtin_amdgcn_make_buffer_rsrc((void*)O, (short)0, 0x7ffffff0, 0x00020000);
        const unsigned off0 = (unsigned)((row0 * ldc + u.pn * pg8::BM + wc * 32 + 8 * fq) * 2);
#pragma unroll
        for (int ai = 0; ai < 2; ++ai)
#pragma unroll
            for (int m = 0; m < 4; ++m) { const unsigned offr = off0 + (unsigned)((ai * pg8::HALF + m * 16) * ldc * 2);
                const float s = rscale ? rscale[row0 + ai * pg8::HALF + m * 16] : 1.0f;
#pragma unroll
                for (int bj = 0; bj < 2; ++bj) { const f32x4 v0 = acc[ai][bj][m][0] * s, v1 = acc[ai][bj][m][1] * s;
                    u32x4 w; w.x = pkbf(v0[0], v0[1]); w.y = pkbf(v0[2], v0[3]); w.z = pkbf(v1[0], v1[1]); w.w = pkbf(v1[2], v1[3]);
                    __builtin_amdgcn_raw_buffer_store_b128(w, rs, offr + (unsigned)(bj * pg8::HALF * 2), 0, 16); } }
    }
};
struct OneUnit {
    int pm, pn;
    __device__ __forceinline__ bool next(int i, pg8::Unit& u) const { if (i != 0) return false; u.pm = pm; u.pn = pn; return true; }
    __device__ __forceinline__ void a_ready(const pg8::Unit&) const {}
    __device__ __forceinline__ void done(const pg8::Unit&) const {}
};
__device__ __forceinline__ void m_phase(const Params& p, int l, LAS unsigned char* lds, const int wid) {
    constexpr int NG1 = (MS / 256) * (DIN / 256), NPJ = (MP / 128) * 12, NJOB = (MT / 128) * 12;
    unsigned* g1done = (unsigned*)(p.ws + WS_Q) + 64 * l;
    int G = (int)gridDim.x; asm volatile("" : "+s"(G));
    const int w = (int)blockIdx.x;
    const bool sched256 = (G == 256);
    bool acq = false;
    for (int it = 0;; ++it) {
        int cur, unit = -1;
        if (sched256) { if (w < NG1) { if (it == 0) { unit = w; cur = 0; } else cur = 2 * (256 - NG1) + (it - 1) * 256 + w; }
                        else cur = it < 2 ? it * (256 - NG1) + (w - NG1) : 2 * (256 - NG1) + (it - 2) * 256 + w; }
        else { const int nu = (NG1 - w + G - 1) / G; if (it < nu) { unit = w + it * G; cur = 0; } else cur = w + (it - nu) * G; }
        if (unit < 0 && cur >= NJOB) break;
        if (unit >= 0) {
            pg8::Gemm g{(const bf16_t*)(p.ws + WS_XN) + (size_t)MP * D, (const bf16_t*)(p.ws + WS_WIN) + (size_t)l * DIN * D, MS, DIN};
            OneUnit S{unit / (DIN / 256), unit % (DIN / 256)};
            EpiStore E{(bf16_t*)(p.ws + WS_Z) + (size_t)MP * DIN, DIN, (const float*)(p.ws + WS_RINV) + MP};
            pg8::gemm_phase<EpiStore, OneUnit, D, D, D, false, G_SP2>(lds, g, S, E, wid * 64 + fresh_lane());
            asm volatile("s_waitcnt vmcnt(0)" ::: "memory");
            __syncthreads();
            if (wid == 0 && fresh_lane() == 0) __hip_atomic_fetch_add(g1done, 1u, RLX_AGENT);
        } else if (cur < NPJ) { const int tch = cur / 96, rem = cur % 96, b = rem / 12, sub = rem % 12, r0 = b * SEQ + tch * 128;
            if (sub < 4) pool_job<false>(p, l, r0, sub, lds, wid); else lru_job<false>(p, l, r0, sub - 4, lds, wid);
        } else { const int jj = cur - NPJ, tile = jj / 12, sub = jj % 12, r0 = MP + tile * 128;
            if (!acq) {
            if (wid == 0) { unsigned spins = 0; while ((unsigned)__builtin_amdgcn_readfirstlane(__hip_atomic_load(g1done, RLX_AGENT)) < (unsigned)NG1) { __builtin_amdgcn_s_sleep(2); if (++spins > (1u << 18)) break; }
                __builtin_amdgcn_fence(__ATOMIC_ACQUIRE, "agent"); asm volatile("s_waitcnt vmcnt(0)" ::: "memory"); }
            __syncthreads(); acq = true; }
            if (sub < 4) pool_job<true>(p, l, r0, sub, lds, wid); else lru_job<true>(p, l, r0, sub - 4, lds, wid);
        }
    }
    const bf16_t* Z = (const bf16_t*)(p.ws + WS_Z);
    if (G == 256 && w >= NG1 && w < 224) return;
    const int tid = wid * 64 + fresh_lane();
    if (!acq) {
    if (wid == 0) { unsigned spins = 0; while ((unsigned)__builtin_amdgcn_readfirstlane(__hip_atomic_load(g1done, RLX_AGENT)) < (unsigned)NG1) { __builtin_amdgcn_s_sleep(2); if (++spins > (1u << 18)) break; }
        __builtin_amdgcn_fence(__ATOMIC_ACQUIRE, "agent"); asm volatile("s_waitcnt vmcnt(0)" ::: "memory"); }
    }
    __syncthreads();
    constexpr int U_PP = NBP * 15 * 128, U_CP = NBP * 3 * 128, U_PS = NBS * 15 * 128, U_CS = NBS * 3 * 128, U_ALL = U_PP + U_CP + U_PS + U_CS;
    const bool s256 = (G == 256);
    if (s256 && w >= NG1 && w < 224) return;
    const int cw = s256 ? (w < NG1 ? w : w - 224 + NG1) : w, ncw = s256 ? NG1 + 32 : G;
    const int nthr = ncw * NTHREADS;
    for (int u0 = cw * NTHREADS + tid; u0 < U_ALL; u0 += 3 * nthr) {
        u32x4 ra[3], rb[3]; float* dst[3]; bool isf[3];
#pragma unroll
        for (int k = 0; k < 3; ++k) {
            int r = u0 + k * nthr; const void* src; isf[k] = false; dst[k] = nullptr;
            if (r >= U_ALL) { src = Z; }
            else if (r < U_PP) { const int c8 = r & 127, rr = (r >> 7) % 15, b = (r >> 7) / 15; src = Z + (size_t)(b * SEQ + SEQ - 15 + rr) * DIN + ZV + c8 * 8; dst[k] = p.out + O_PP + (((size_t)l * NBP + b) * 15 + rr) * 1024 + c8 * 8; }
            else if ((r -= U_PP) < U_CP) { const int c8 = r & 127, rr = (r >> 7) % 3, b = (r >> 7) / 3; src = Z + (size_t)(b * SEQ + SEQ - 3 + rr) * DIN + ZU + c8 * 8; dst[k] = p.out + O_CP + (((size_t)l * NBP + b) * 3 + rr) * 1024 + c8 * 8; }
            else if ((r -= U_CP) < U_PS) { const int c8 = r & 127, rr = (r >> 7) % 15, s = (r >> 7) / 15;
                if (rr < 7) { src = p.st_pool + (((size_t)l * NBS + s) * 15 + 8 + rr) * 1024 + c8 * 8; isf[k] = true; } else src = Z + (size_t)(MP + s * TS + rr - 7) * DIN + ZV + c8 * 8;
                dst[k] = p.out + O_PS + (((size_t)l * NBS + s) * 15 + rr) * 1024 + c8 * 8; }
            else { r -= U_PS; const int c8 = r & 127, rr = (r >> 7) % 3, s = (r >> 7) / 3; src = Z + (size_t)(MP + s * TS + 5 + rr) * DIN + ZU + c8 * 8; dst[k] = p.out + O_CS + (((size_t)l * NBS + s) * 3 + rr) * 1024 + c8 * 8; }
            ra[k] = *(const u32x4*)src; rb[k] = ra[k]; if (isf[k]) rb[k] = *((const u32x4*)src + 1);
        }
#pragma unroll
        for (int k = 0; k < 3; ++k) if (dst[k]) {
            if (isf[k]) { *(u32x4*)dst[k] = ra[k]; *(u32x4*)(dst[k] + 4) = rb[k]; }
            else { float v[8]; unpack8(ra[k], v); *(f32x4*)dst[k] = (f32x4){v[0], v[1], v[2], v[3]}; *(f32x4*)(dst[k] + 4) = (f32x4){v[4], v[5], v[6], v[7]}; }
        }
    }
}

#define XB_TMO      128
#define XB_XCNT(j)  (256  + 64 * (j))
#define XB_XSUB(j)  (1280 + 64 * (j))
#define XB_XGEN(j)  (2304 + 64 * (j))
#define XB_TOP      3328
#define XB_TOPGEN   3392
#define XCD_BAR_WORDS 3456
#define XB_SPIN_CAP (1u << 18)

__device__ __forceinline__ unsigned xb_ld(unsigned* p)              { return __hip_atomic_load(p, __ATOMIC_RELAXED, __HIP_MEMORY_SCOPE_AGENT); }
__device__ __forceinline__ unsigned xb_add(unsigned* p, unsigned v) { return __hip_atomic_fetch_add(p, v, __ATOMIC_RELAXED, __HIP_MEMORY_SCOPE_AGENT); }
__device__ __forceinline__ unsigned xb_xcc_id() { return (unsigned)__builtin_amdgcn_s_getreg((3 << 11) | 20) & 0xFu; }
#define XB_SPIN(cond, bar) do { unsigned _sp = 0; while (cond) { __builtin_amdgcn_s_sleep(1); \
    if ((++_sp & 255u) == 0u) { if (xb_ld(&(bar)[XB_TMO])) break; if (_sp > XB_SPIN_CAP) { atomicAdd(&(bar)[XB_TMO], 1u); break; } } } } while (0)

struct XcdBarrier {
    unsigned* bar; unsigned x;
    volatile LAS unsigned* st;
};

__device__ __forceinline__ XcdBarrier xcd_barrier_post(unsigned* bar, volatile LAS unsigned* st, bool leader) {
    XcdBarrier b; b.bar = bar; b.x = xb_xcc_id(); b.st = st;
    if (leader) (void)xb_add(&bar[XB_XCNT(b.x)], 1u);
    return b;
}
__device__ __forceinline__ void xcd_barrier_complete(unsigned* bar, unsigned x, unsigned& nloc, unsigned& nx) {
    const unsigned G = gridDim.x * gridDim.y * gridDim.z;
    unsigned sum, cnt, mine, sp = 0u;
    for (;;) {
        sum = 0u; cnt = 0u; mine = 0u;
#pragma unroll
        for (unsigned j = 0; j < 16; ++j) { const unsigned c = xb_ld(&bar[XB_XCNT(j)]); sum += c; cnt += (c > 0u) ? 1u : 0u; mine = (j == x) ? c : mine; }
        if (sum == G) break;
        __builtin_amdgcn_s_sleep(1);
        if ((++sp & 255u) == 0u) { if (xb_ld(&bar[XB_TMO])) break; if (sp > XB_SPIN_CAP) { atomicAdd(&bar[XB_TMO], 1u); break; } }
    }
    nloc = mine > 0u ? mine : 1u; nx = cnt > 0u ? cnt : 1u;
}

__device__ __forceinline__ void xcd_barrier(const XcdBarrier& b, bool leader) {
    asm volatile("s_waitcnt vmcnt(0)" ::: "memory");
    __syncthreads();
    if (leader) {
        unsigned* bar = b.bar;
        __builtin_amdgcn_s_waitcnt(0);
        unsigned nloc = b.st[0], nx = b.st[1];
        if (nloc == 0u) { xcd_barrier_complete(bar, b.x, nloc, nx); b.st[0] = nloc; b.st[1] = nx; }
        const unsigned old = xb_add(&bar[XB_XSUB(b.x)], 1u);
        const unsigned gen = old / nloc;
        if (old + 1u == (gen + 1u) * nloc) {
            __builtin_amdgcn_fence(__ATOMIC_RELEASE, "agent");
            asm volatile("s_waitcnt vmcnt(0)" ::: "memory");
            const unsigned og = xb_add(&bar[XB_TOP], 1u);
            const unsigned tg = og / nx;
            if (og + 1u == (tg + 1u) * nx) xb_add(&bar[XB_TOPGEN], 1u);
            else XB_SPIN(xb_ld(&bar[XB_TOPGEN]) == tg, bar);
            __builtin_amdgcn_fence(__ATOMIC_ACQUIRE, "agent");
            xb_add(&bar[XB_XGEN(b.x)], 1u);
            asm volatile("s_waitcnt vmcnt(0)" ::: "memory");
        } else {
            XB_SPIN(xb_ld(&bar[XB_XGEN(b.x)]) == gen, bar);
            __builtin_amdgcn_fence(__ATOMIC_ACQUIRE, "agent");
            asm volatile("s_waitcnt vmcnt(0)" ::: "memory");
        }
    }
    __syncthreads();
}

__global__ void __launch_bounds__(NTHREADS, 2) hymba_fwd(Params p) {
    extern __shared__ __attribute__((aligned(16))) unsigned char lds_raw[];
    LAS unsigned char* lds = (LAS unsigned char*)lds_raw;
    cg::grid_group grid = cg::this_grid();
    const int G = gridDim.x, NGW = G * NWAVES;
#define FT() (wid_s * 64 + fresh_lane())
    const int wid_s = __builtin_amdgcn_readfirstlane((int)threadIdx.x >> 6);
#define FRESH_TID() int wid_o = wid_s; asm volatile("" : "+s"(wid_o)); const int lane = fresh_lane(), wid = wid_o, tid = wid * 64 + lane, gw = blockIdx.x * NWAVES + wid; (void)gw; (void)tid
    bf16_t* XN = (bf16_t*)(p.ws + WS_XN); bf16_t* Z = (bf16_t*)(p.ws + WS_Z);

    if (blockIdx.x == 0) { for (int i = FT(); i < XCD_BAR_WORDS; i += NTHREADS) __hip_atomic_store((unsigned*)(p.ws + WS_BAR) + i, 0u, RLX_AGENT);
        if (FT() < 8) __hip_atomic_store((unsigned*)(p.ws + WS_Q) + 64 * FT(), 0u, RLX_AGENT); }
    if (FT() < 2) ((volatile LAS unsigned*)(lds + 131072))[FT()] = 0u;
    grid.sync();
    const XcdBarrier xbar = xcd_barrier_post((unsigned*)(p.ws + WS_BAR), (volatile LAS unsigned*)(lds + 131072), FT() == 0);
#ifndef NO_P0
    { FRESH_TID(); p0_phase(p, lds, gw, NGW, wid, lane); }
#endif
    xcd_barrier(xbar, FT() == 0);
#pragma unroll 1
    for (int l = 0; l < DEPTH; ++l) {
        {
            pg8::Gemm g{XN, (const bf16_t*)(p.ws + WS_WIN) + (size_t)l * DIN * D, MP, DIN};
            pg8::StaticOrder S; S.init(MP, DIN, G, (int)blockIdx.x);
            EpiStore E{Z, DIN, (const float*)(p.ws + WS_RINV)};
            pg8::gemm_phase<EpiStore, pg8::StaticOrder, D, D, D, G_ALIGN, G_SP2>(lds, g, S, E, FT());
        }
        xcd_barrier(xbar, FT() == 0);
#ifndef NO_M
        m_phase(p, l, lds, wid_s);
#endif
        xcd_barrier(xbar, FT() == 0);
        {
            pg8::Gemm g{Z + ZGP, (const bf16_t*)(p.ws + WS_WOUT) + (size_t)l * D * 2048, MP, D};
            pg8::StaticOrder S; S.init(MP, D, G, (int)blockIdx.x);
            EpiStore E{Z + ZV, DIN, nullptr};
            pg8::gemm_phase<EpiStore, pg8::StaticOrder, 2048, DIN, 2048, G_ALIGN, G_SP2>(lds, g, S, E, FT());
        }
        xcd_barrier(xbar, FT() == 0);
        constexpr int NSG = (MS / 256) * (D / 256), KS = 4;
        int Gl = G; asm volatile("" : "+s"(Gl));
        if (Gl > 2 * KS * NSG) {
            if ((int)blockIdx.x < KS * NSG) {
                const int ks = (int)blockIdx.x / NSG;
                pg8::Gemm g{Z + (size_t)MP * DIN + ZGP + ks * (2048 / KS), (const bf16_t*)(p.ws + WS_WOUT) + (size_t)l * D * 2048 + ks * (2048 / KS), MS, D};
                pg8::StaticOrder S; S.init(MS, D, NSG, (int)blockIdx.x % NSG);
                EpiStore E{ks < 2 ? Z + (size_t)MP * DIN + (ks ? ZU : ZV) : (bf16_t*)(p.ws + WS_PART) + (size_t)(ks - 2) * MS * D, ks < 2 ? DIN : D, nullptr};
                pg8::gemm_phase<EpiStore, pg8::StaticOrder, 2048 / KS, DIN, 2048, G_ALIGN, G_SP2>(lds, g, S, E, FT());
                unsigned* fsdone = (unsigned*)(p.ws + WS_Q) + 64 * (4 + l);
                asm volatile("s_waitcnt vmcnt(0)" ::: "memory");
                __syncthreads();
                if (FT() == 0) __hip_atomic_fetch_add(fsdone, 1u, RLX_AGENT);
                if (wid_s == 0) { unsigned spins = 0; while ((unsigned)__builtin_amdgcn_readfirstlane(__hip_atomic_load(fsdone, RLX_AGENT)) < (unsigned)(KS * NSG)) { __builtin_amdgcn_s_sleep(2); if (++spins > (1u << 18)) break; }
                    __builtin_amdgcn_fence(__ATOMIC_ACQUIRE, "agent"); asm volatile("s_waitcnt vmcnt(0)" ::: "memory"); }
                __syncthreads();
                { FRESH_TID(); f_phase<4>(p, l, MP, MT, gw, KS * NSG * NWAVES, lane); }
            } else {
                FRESH_TID(); f_phase<1>(p, l, 0, MP, gw - KS * NSG * NWAVES, NGW - KS * NSG * NWAVES, lane);
            }
        } else {
            for (int ks = 0; ks < KS; ++ks) { pg8::Gemm g{Z + (size_t)MP * DIN + ZGP + ks * (2048 / KS), (const bf16_t*)(p.ws + WS_WOUT) + (size_t)l * D * 2048 + ks * (2048 / KS), MS, D};
              pg8::StaticOrder S; S.init(MS, D, G, (int)blockIdx.x);
              EpiStore E{ks < 2 ? Z + (size_t)MP * DIN + (ks ? ZU : ZV) : (bf16_t*)(p.ws + WS_PART) + (size_t)(ks - 2) * MS * D, ks < 2 ? DIN : D, nullptr};
              pg8::gemm_phase<EpiStore, pg8::StaticOrder, 2048 / KS, DIN, 2048, G_ALIGN, G_SP2>(lds, g, S, E, FT()); }
            { FRESH_TID(); f_phase<1>(p, l, 0, MP, gw, NGW, lane); }
            xcd_barrier(xbar, FT() == 0);
            { FRESH_TID(); f_phase<4>(p, l, MP, MT, gw, NGW, lane); }
        }
        if (l < DEPTH - 1) xcd_barrier(xbar, FT() == 0);
    }
}

extern "C" void kernel_launch(void* const* d_in, const int* in_sizes, int n_in, void* d_out, int out_size, void* d_ws, size_t ws_size, hipStream_t stream) {
    static int grid = 0;
    if (grid == 0) {
        if (n_in != 18 || (size_t)out_size != O_END || ws_size < WS_BAR + 65536) { fprintf(stderr, "kernel_launch: unexpected shapes (n_in %d out %d ws %zu)\n", n_in, out_size, ws_size); grid = -1; return; }
        int dev = 0, cus = 0, per_cu = 0;
        if (hipGetDevice(&dev) != hipSuccess || hipDeviceGetAttribute(&cus, hipDeviceAttributeMultiprocessorCount, dev) != hipSuccess) { grid = -1; return; }
        if (hipFuncSetAttribute((const void*)hymba_fwd, hipFuncAttributeMaxDynamicSharedMemorySize, LDS_BYTES) != hipSuccess) { fprintf(stderr, "kernel_launch: hipFuncSetAttribute failed\n"); grid = -1; return; }
        if (hipOccupancyMaxActiveBlocksPerMultiprocessor(&per_cu, (const void*)hymba_fwd, NTHREADS, LDS_BYTES) != hipSuccess || per_cu < 1) { fprintf(stderr, "kernel_launch: occupancy query failed (%d)\n", per_cu); grid = -1; return; }
        grid = cus * per_cu;
    }
    if (grid < 0) return;
    Params p{};
    p.xp = (const float*)d_in[0]; p.xs = (const float*)d_in[1]; p.st_pool = (const float*)d_in[2]; p.st_conv = (const float*)d_in[3]; p.st_lru = (const float*)d_in[4];
    p.norm_pre = (const float*)d_in[5]; p.norm_post = (const float*)d_in[6]; p.w_in = (const float*)d_in[7]; p.pool_w = (const float*)d_in[8]; p.pool_scale = (const float*)d_in[9];
    p.conv_w = (const float*)d_in[10]; p.conv_b = (const float*)d_in[11]; p.lru_wa = (const float*)d_in[12]; p.lru_ba = (const float*)d_in[13]; p.lru_wx = (const float*)d_in[14];
    p.lru_bx = (const float*)d_in[15]; p.lru_lam = (const float*)d_in[16]; p.w_out = (const float*)d_in[17]; p.out = (float*)d_out; p.ws = (unsigned char*)d_ws;
    void* args[] = {&p};
    hipError_t e = hipLaunchCooperativeKernel((const void*)hymba_fwd, dim3(grid), dim3(NTHREADS), args, LDS_BYTES, stream);
    if (e != hipSuccess) fprintf(stderr, "kernel_launch: cooperative launch failed: %s (grid %d)\n", hipGetErrorString(e), grid);
}
```

```cpp
#include <hip/hip_runtime.h>
#include <hip/hip_cooperative_groups.h>
#include <cstdio>
namespace cg = cooperative_groups;
namespace pg8 {
#define PG8_LAS __attribute__((address_space(3)))
typedef unsigned short bf16_t;
typedef short bf16x8 __attribute__((ext_vector_type(8)));
typedef float f32x4 __attribute__((ext_vector_type(4)));
typedef unsigned u32x4 __attribute__((ext_vector_type(4)));
constexpr int BM = 256, BK = 64, HALF = 128, HTB = HALF * BK * 2  , STAGE_BYTES = 8 * HTB, NXCD = 8, WGM = 8;

__host__ __device__ __forceinline__ int lds_byte(int r, int c) { const int st = (r >> 4) * 2 + (c >> 5), rr = r & 15, cc = c & 31, ob = rr * 64 + cc * 2; return st * 1024 + (ob ^ (((ob >> 9) & 1) << 5)); }
__host__ __device__ __forceinline__ void stage_rc(int b, int& R, int& C) { const int st = b / 1024, sb = b % 1024, swz = sb ^ (((sb >> 9) & 1) << 5); R = (st >> 1) * 16 + swz / 64; C = (st & 1) * 32 + (swz % 64) / 2; }
__host__ __device__ __forceinline__ int perm32(int rho) { const int n = rho >> 4, i = rho & 15; return 8 * (i >> 2) + 4 * n + (i & 3); }

struct Unit { int pm, pn; };
struct Gemm { const bf16_t* A; const bf16_t* Bt; int M, N; };

struct StaticOrder {
    int nM, nN, nwg, G, c;
    __host__ __device__ void init(int M, int N, int G_, int c_) { nM = M / BM; nN = N / BM; nwg = nM * nN; G = G_; c = c_; }
    __host__ __device__ bool next(int i, Unit& u) const {
        const long L = (long)i * G + c; if (L >= nwg) return false;
        int wgid = (int)L; { const int q = nwg / NXCD, r = nwg % NXCD, xcd = wgid % NXCD, off = wgid / NXCD; wgid = (xcd < r ? xcd * (q + 1) : r * (q + 1) + (xcd - r) * q) + off; }
        const int nig = WGM * nN, gid = wgid / nig, fm = gid * WGM, gsz = (nM - fm) < WGM ? (nM - fm) : WGM;
        u.pm = fm + ((wgid % nig) % gsz); u.pn = (wgid % nig) / gsz; return true;
    }
    __device__ __forceinline__ void a_ready(const Unit&) const {}
    __device__ __forceinline__ void done(const Unit&) const {}
};

__device__ __forceinline__ unsigned cvt_pk_bf16(float lo, float hi) { unsigned r; asm volatile("v_cvt_pk_bf16_f32 %0, %1, %2" : "=v"(r) : "v"(lo), "v"(hi)); return r; }
typedef float f32x2 __attribute__((ext_vector_type(2)));
__device__ __forceinline__ f32x2 gelu_pk(f32x2 v) {
    const f32x2 av = __builtin_elementwise_abs(v), d = av * 0.2316418882f + 1.0f;
    f32x2 t; t.x = __builtin_amdgcn_rcpf(d.x); t.y = __builtin_amdgcn_rcpf(d.y);
    f32x2 q = t * 0.5307027145f + (-0.7265760135f); q = q * t + 0.7107068705f; q = q * t + (-0.142248368f); q = q * t + 0.127414796f; q = q * t;
    const f32x2 s = (v * v) * (-0.72134752044f);
    f32x2 e; e.x = __builtin_amdgcn_exp2f(s.x); e.y = __builtin_amdgcn_exp2f(s.y);
    const f32x2 m = v * (q * e), r = v - m;
    f32x2 o; o.x = v.x < 0.f ? m.x : r.x; o.y = v.y < 0.f ? m.y : r.y; return o;
}

template <int ACT  > struct EpiBf16 {
    static constexpr bool PERM = true, AFTER_DRAIN = false; static_assert(ACT == 0 || ACT == 1, "EpiBf16: ACT is 0 (none) or 1 (gelu_pk)");
    bf16_t* O; int ldc; const float* bias; int split_cols; size_t split_stride; float scale0;
    __device__ __forceinline__ void operator()(const f32x4 (&acc)[2][2][4][2], const Unit& u, int wr, int wc, int fr, int fq) const {
        const int row0 = u.pm * BM + wr * 64 + fr; int colt = u.pn * BM; bf16_t* base = O;
        float sc = 1.f; if (split_cols) { const int t = colt / split_cols; base += (size_t)t * split_stride; colt -= t * split_cols; if (t == 0) sc = scale0; }
        const int col0 = colt + wc * 32 + 8 * fq, bcol0 = u.pn * BM + wc * 32 + 8 * fq;
        f32x4 bv[2][2];
#pragma unroll
        for (int bj = 0; bj < 2; ++bj)
#pragma unroll
            for (int n = 0; n < 2; ++n) bv[bj][n] = bias ? *(const f32x4*)(bias + bcol0 + bj * HALF + 4 * n) : (f32x4){0.f, 0.f, 0.f, 0.f};
#pragma unroll
        for (int ai = 0; ai < 2; ++ai)
#pragma unroll
            for (int m = 0; m < 4; ++m) { bf16_t* rowp = base + (size_t)(row0 + ai * HALF + m * 16) * ldc + col0;
#pragma unroll
                for (int bj = 0; bj < 2; ++bj) { f32x4 v0 = acc[ai][bj][m][0] + bv[bj][0], v1 = acc[ai][bj][m][1] + bv[bj][1];
                    if (ACT == 1) { f32x2 a = gelu_pk((f32x2){v0[0], v0[1]}), b = gelu_pk((f32x2){v0[2], v0[3]}), c = gelu_pk((f32x2){v1[0], v1[1]}), d = gelu_pk((f32x2){v1[2], v1[3]});
                        v0 = (f32x4){a.x, a.y, b.x, b.y}; v1 = (f32x4){c.x, c.y, d.x, d.y}; }
                    v0 = v0 * sc; v1 = v1 * sc; u32x4 w; w.x = cvt_pk_bf16(v0[0], v0[1]); w.y = cvt_pk_bf16(v0[2], v0[3]); w.z = cvt_pk_bf16(v1[0], v1[1]); w.w = cvt_pk_bf16(v1[2], v1[3]);
                    *(u32x4*)(rowp + bj * HALF) = w; } }
    }
};
template <class Epi, class Sched, int KK, int LDA, int LDB, bool ALIGN_EPI = false, bool SP2 = false>
__device__ __forceinline__ void gemm_phase(PG8_LAS unsigned char* lds, const Gemm g, const Sched& S, const Epi& E, const int tid) {
    const int wid = __builtin_amdgcn_readfirstlane(tid >> 6), lane = tid & 63, wr = wid >> 2, wc = wid & 3, fr = lane & 15, fq = lane >> 4;
    constexpr int K = KK, nt = K / BK;
    unsigned voffA[2], voffB[2];
#pragma unroll
    for (int i = 0; i < 2; ++i) { int R, C; stage_rc(tid * 16 + i * 8192, R, C); const int Rb = Epi::PERM ? ((R & ~31) + perm32(R & 31)) : R;
        voffA[i] = (unsigned)(R * LDA + C) * 2u; voffB[i] = (unsigned)(Rb * LDB + C) * 2u; }
    const size_t kstep = (size_t)(BK * 2);
    constexpr size_t hstepB = (size_t)HALF * LDB * 2, hstepA = (size_t)HALF * LDA * 2;
    constexpr size_t tstepB = 2 * hstepB, tstepA = 2 * hstepA;
    const unsigned ldsw = (unsigned)wid * 1024u;
    const int aoff = lds_byte(wr * 64 + fr, fq * 8), boff = lds_byte(wc * 32 + fr, fq * 8);
#define PG8_SA(b, h) (((b) * 2 + (h)) * HTB)
#define PG8_SB(b, h) ((4 + (b) * 2 + (h)) * HTB)
#define PG8_STAGE(bufoff, gbase, voff) do { _Pragma("unroll") for (int _i = 0; _i < 2; ++_i) \
        __builtin_amdgcn_global_load_lds((const unsigned*)((const char*)(gbase) + (voff)[_i]), (PG8_LAS unsigned*)(lds + (bufoff) + ldsw + _i * 8192), 16, 0, 0); } while (0)
#define PG8_LDA(dst, b, h) do { _Pragma("unroll") for (int m = 0; m < 4; ++m) _Pragma("unroll") for (int k = 0; k < 2; ++k) dst[m][k] = *(const PG8_LAS bf16x8*)(lds + PG8_SA(b, h) + aoff + m * 2048 + k * 1024); } while (0)
#define PG8_LDB(dst, b, h) do { _Pragma("unroll") for (int n = 0; n < 2; ++n) _Pragma("unroll") for (int k = 0; k < 2; ++k) dst[n][k] = *(const PG8_LAS bf16x8*)(lds + PG8_SB(b, h) + boff + n * 2048 + k * 1024); } while (0)
#define PG8_MMA(ai, bj, At, Bt) do { __builtin_amdgcn_s_setprio(1); _Pragma("unroll") for (int m = 0; m < 4; ++m) _Pragma("unroll") for (int n = 0; n < 2; ++n) _Pragma("unroll") for (int k = 0; k < 2; ++k) \
        acc[ai][bj][m][n] = __builtin_amdgcn_mfma_f32_16x16x32_bf16(Bt[n][k], At[m][k], acc[ai][bj][m][n], 0, 0, 0); __builtin_amdgcn_s_setprio(0); } while (0)
#define PG8_WAIT_V(n) asm volatile("s_waitcnt vmcnt(" #n ")" ::: "memory")
#define PG8_WAIT_L(n) asm volatile("s_waitcnt lgkmcnt(" #n ")" ::: "memory")
#define PG8_BAR __builtin_amdgcn_s_barrier()
#define PG8_SCHED __builtin_amdgcn_sched_barrier(0)
    Unit cur, nxt; int ui = 0;
    if (!S.next(0, cur)) return;
    const char* cA = (const char*)g.A + (size_t)cur.pm * tstepA; const char* cB = (const char*)g.Bt + (size_t)cur.pn * tstepB;
    S.a_ready(cur);
    if constexpr (SP2) {
        PG8_STAGE(PG8_SB(0, 0), cB, voffB); PG8_STAGE(PG8_SB(0, 1), cB + hstepB, voffB); PG8_STAGE(PG8_SA(0, 0), cA, voffA); PG8_STAGE(PG8_SA(0, 1), cA + hstepA, voffA);
        if (wr == 1) PG8_BAR;
        PG8_WAIT_V(2); PG8_BAR;
        PG8_STAGE(PG8_SB(1, 0), cB + kstep, voffB); PG8_STAGE(PG8_SA(1, 0), cA + kstep, voffA); PG8_STAGE(PG8_SB(1, 1), cB + hstepB + kstep, voffB);
        PG8_WAIT_V(6); PG8_BAR;
    } else {
        PG8_STAGE(PG8_SB(0, 0), cB, voffB); PG8_STAGE(PG8_SA(0, 0), cA, voffA); PG8_STAGE(PG8_SB(0, 1), cB + hstepB, voffB); PG8_STAGE(PG8_SA(0, 1), cA + hstepA, voffA);
        if (wr == 1) PG8_BAR;
        PG8_WAIT_V(4); PG8_BAR;
        PG8_STAGE(PG8_SB(1, 0), cB + kstep, voffB); PG8_STAGE(PG8_SA(1, 0), cA + kstep, voffA); PG8_STAGE(PG8_SB(1, 1), cB + hstepB + kstep, voffB);
        PG8_WAIT_V(6); PG8_BAR;
    }
    f32x4 acc[2][2][4][2];
#pragma unroll
    for (int a = 0; a < 2; ++a)
#pragma unroll
        for (int b = 0; b < 2; ++b)
#pragma unroll
            for (int m = 0; m < 4; ++m)
#pragma unroll
                for (int n = 0; n < 2; ++n) acc[a][b][m][n] = (f32x4){0.f, 0.f, 0.f, 0.f};
    bf16x8 At[4][2], B0[2][2], B1[2][2];
    for (;;) {
        const bool has_next = S.next(ui + 1, nxt);
        const char* nA = has_next ? (const char*)g.A + (size_t)nxt.pm * tstepA : cA; const char* nB = has_next ? (const char*)g.Bt + (size_t)nxt.pn * tstepB : cB;
        for (int t = 0; t < nt; t += 2) {
            const bool last = (t == nt - 2);
            const char* a1 = cA + (size_t)(t + 1) * kstep;
            const char* a2 = last ? nA : cA + (size_t)(t + 2) * kstep; const char* b2 = last ? nB : cB + (size_t)(t + 2) * kstep;
            const char* a3 = a2 + kstep; const char* b3 = b2 + kstep;
            if (last && has_next) S.a_ready(nxt);
            if constexpr (SP2) {
            PG8_LDB(B0, 0, 0); PG8_LDB(B1, 0, 1); PG8_SCHED; PG8_LDA(At, 0, 0); PG8_STAGE(PG8_SA(1, 1), a1 + hstepA, voffA);
            PG8_WAIT_V(8); PG8_WAIT_L(0); PG8_BAR; PG8_MMA(0, 0, At, B0); PG8_MMA(0, 1, At, B1); PG8_BAR; PG8_SCHED;
            PG8_LDA(At, 0, 1); PG8_STAGE(PG8_SB(0, 0), b2, voffB); PG8_STAGE(PG8_SB(0, 1), b2 + hstepB, voffB); PG8_STAGE(PG8_SA(0, 0), a2, voffA);
            PG8_WAIT_V(8); PG8_WAIT_L(0); PG8_BAR; PG8_MMA(1, 0, At, B0); PG8_MMA(1, 1, At, B1); PG8_BAR; PG8_SCHED;
            PG8_LDB(B0, 1, 0); PG8_LDB(B1, 1, 1); PG8_SCHED; PG8_LDA(At, 1, 0); PG8_STAGE(PG8_SA(0, 1), a2 + hstepA, voffA);
            PG8_WAIT_V(8); PG8_WAIT_L(0); PG8_BAR; PG8_MMA(0, 0, At, B0); PG8_MMA(0, 1, At, B1); PG8_BAR; PG8_SCHED;
            PG8_LDA(At, 1, 1); PG8_STAGE(PG8_SB(1, 0), b3, voffB); PG8_STAGE(PG8_SB(1, 1), b3 + hstepB, voffB); PG8_STAGE(PG8_SA(1, 0), a3, voffA);
            PG8_WAIT_V(8); PG8_WAIT_L(0); PG8_BAR; PG8_MMA(1, 0, At, B0); PG8_MMA(1, 1, At, B1); PG8_BAR; PG8_SCHED;
            } else {
            PG8_LDB(B0, 0, 0); PG8_SCHED; PG8_LDA(At, 0, 0); PG8_STAGE(PG8_SA(1, 1), a1 + hstepA, voffA);
            PG8_WAIT_L(8); PG8_BAR; PG8_WAIT_L(0); PG8_MMA(0, 0, At, B0); PG8_BAR; PG8_SCHED;
            PG8_LDB(B1, 0, 1); PG8_STAGE(PG8_SB(0, 0), b2, voffB);
            PG8_BAR; PG8_WAIT_L(0); PG8_MMA(0, 1, At, B1); PG8_BAR;
            PG8_LDA(At, 0, 1); PG8_STAGE(PG8_SA(0, 0), a2, voffA);
            PG8_BAR; PG8_WAIT_L(0); PG8_MMA(1, 0, At, B0); PG8_BAR; PG8_SCHED;
            PG8_STAGE(PG8_SB(0, 1), b2 + hstepB, voffB);
            PG8_WAIT_V(6); PG8_BAR; PG8_MMA(1, 1, At, B1); PG8_BAR;
            PG8_LDB(B0, 1, 0); PG8_SCHED; PG8_LDA(At, 1, 0); PG8_STAGE(PG8_SA(0, 1), a2 + hstepA, voffA);
            PG8_WAIT_L(8); PG8_BAR; PG8_WAIT_L(0); PG8_MMA(0, 0, At, B0); PG8_BAR; PG8_SCHED;
            PG8_LDB(B1, 1, 1); PG8_STAGE(PG8_SB(1, 0), b3, voffB);
            PG8_BAR; PG8_WAIT_L(0); PG8_MMA(0, 1, At, B1); PG8_BAR;
            PG8_LDA(At, 1, 1); PG8_STAGE(PG8_SA(1, 0), a3, voffA);
            PG8_BAR; PG8_WAIT_L(0); PG8_MMA(1, 0, At, B0); PG8_BAR; PG8_SCHED;
            PG8_STAGE(PG8_SB(1, 1), b3 + hstepB, voffB);
            PG8_WAIT_V(6); PG8_BAR; PG8_MMA(1, 1, At, B1); PG8_BAR;
            }
        }
        if constexpr (ALIGN_EPI) { if (wr == 0) PG8_BAR; }
        if constexpr (!Epi::AFTER_DRAIN) { E(acc, cur, wr, wc, fr, fq); S.done(cur); }
        if (!has_next) break;
#pragma unroll
        for (int a = 0; a < 2; ++a)
#pragma unroll
            for (int b = 0; b < 2; ++b)
#pragma unroll
                for (int m = 0; m < 4; ++m)
#pragma unroll
                    for (int n = 0; n < 2; ++n) acc[a][b][m][n] = (f32x4){0.f, 0.f, 0.f, 0.f};
        cur = nxt; cA = nA; cB = nB; ++ui;
        if constexpr (ALIGN_EPI) { if (wr == 1) PG8_BAR; }
    }
    PG8_WAIT_V(0);
    if constexpr (!ALIGN_EPI) { if (wr == 0) PG8_BAR; }
    PG8_BAR;
    if constexpr (Epi::AFTER_DRAIN) { E.fused(acc, cur, wr, wc, fr, fq, lds, wid, lane); S.done(cur); }
#undef PG8_SA
#undef PG8_SB
#undef PG8_STAGE
#undef PG8_LDA
#undef PG8_LDB
#undef PG8_MMA
#undef PG8_WAIT_V
#undef PG8_WAIT_L
#undef PG8_BAR
#undef PG8_SCHED
}
}

#define GAS __attribute__((address_space(1)))
#define LAS __attribute__((address_space(3)))
typedef unsigned short bf16_t;
typedef short bf16x8 __attribute__((ext_vector_type(8)));
typedef float f32x4 __attribute__((ext_vector_type(4)));
typedef unsigned u32x4 __attribute__((ext_vector_type(4)));
typedef unsigned u32x2 __attribute__((ext_vector_type(2)));
typedef GAS unsigned long long gu64;
#define RLX_AGENT __ATOMIC_RELAXED, __HIP_MEMORY_SCOPE_AGENT

constexpr int D = 1024, DIN = 4096, SEQ = 2048, NBP = 8, MP = NBP * SEQ, NBS = 128, TS = 8, MS = NBS * TS, MT = MP + MS, DEPTH = 4;
constexpr int ZV = 0, ZU = 1024, ZGP = 2048, ZGL = 3072;
constexpr int NCHUNK = SEQ / 128;
constexpr float EPS = 1e-6f, LOG2E = 1.4426950408889634f;
constexpr unsigned CTAG = 0x5A17C0DEu;

constexpr size_t MiB = 1u << 20;
constexpr size_t WS_CARRY = 0;
constexpr size_t WS_WIN = 4 * MiB;
constexpr size_t WS_WOUT = 36 * MiB;
constexpr size_t WS_POOLW = 52 * MiB;
constexpr size_t WS_WA = 54 * MiB, WS_WX = 55 * MiB;
constexpr size_t WS_XN = 56 * MiB;
constexpr size_t WS_Z = 90 * MiB;
constexpr size_t WS_END = WS_Z + (size_t)MT * DIN * 2;
constexpr size_t WS_LC = 235 * MiB;
constexpr size_t WS_PART = 228 * MiB;
constexpr size_t WS_RINV = 236 * MiB;
constexpr size_t WS_Q = 239 * MiB;
constexpr size_t WS_BAR = 240 * MiB;
static_assert(WS_XN + (size_t)MT * D * 2 <= WS_Z && WS_END <= WS_BAR, "ws map");

constexpr size_t O_YP = 0, O_YS = (size_t)MP * D, O_PP = O_YS + (size_t)MS * D, O_CP = O_PP + (size_t)DEPTH * NBP * 15 * 1024,
                 O_LP = O_CP + (size_t)DEPTH * NBP * 3 * 1024, O_PS = O_LP + (size_t)DEPTH * NBP * 1024, O_CS = O_PS + (size_t)DEPTH * NBS * 15 * 1024,
                 O_LS = O_CS + (size_t)DEPTH * NBS * 3 * 1024, O_END = O_LS + (size_t)DEPTH * NBS * 1024;

constexpr int LDS_BYTES = 131072 + 4096;
constexpr int NTHREADS = 512, NWAVES = 8;

struct Params {
    const float* xp; const float* xs; const float* st_pool; const float* st_conv; const float* st_lru; const float* norm_pre; const float* norm_post; const float* w_in;
    const float* pool_w; const float* pool_scale; const float* conv_w; const float* conv_b; const float* lru_wa; const float* lru_ba; const float* lru_wx; const float* lru_bx;
    const float* lru_lam; const float* w_out; float* out; unsigned char* ws;
};

__device__ __forceinline__ float bf2f(unsigned b) { return __uint_as_float(b << 16); }
__device__ __forceinline__ unsigned pkbf(float lo, float hi) { return pg8::cvt_pk_bf16(lo, hi); }
__device__ __forceinline__ int fresh_lane() { int l; asm volatile("v_mbcnt_lo_u32_b32 %0, -1, 0\n\tv_mbcnt_hi_u32_b32 %0, -1, %0" : "=v"(l)); return l; }
__device__ __forceinline__ float shfl_lane(float v, int src) { return __int_as_float(__builtin_amdgcn_ds_bpermute(src << 2, __float_as_int(v))); }
__device__ __forceinline__ float wave_sum(float v, int lane) {
#pragma unroll
    for (int o = 1; o < 64; o <<= 1) v += shfl_lane(v, lane ^ o);
    return v;
}
__device__ __forceinline__ void unpack8(const u32x4 w, float (&v)[8]) {
    v[0] = __uint_as_float(w.x << 16); v[1] = __uint_as_float(w.x & 0xffff0000u); v[2] = __uint_as_float(w.y << 16); v[3] = __uint_as_float(w.y & 0xffff0000u);
    v[4] = __uint_as_float(w.z << 16); v[5] = __uint_as_float(w.z & 0xffff0000u); v[6] = __uint_as_float(w.w << 16); v[7] = __uint_as_float(w.w & 0xffff0000u);
}
__device__ __forceinline__ void ldbf8(const bf16_t* p, float (&v)[8]) { unpack8(*(const u32x4*)p, v); }
__device__ __forceinline__ void ldf8(const float* p, float (&v)[8]) { const f32x4 a = *(const f32x4*)p, b = *(const f32x4*)(p + 4); v[0] = a.x; v[1] = a.y; v[2] = a.z; v[3] = a.w; v[4] = b.x; v[5] = b.y; v[6] = b.z; v[7] = b.w; }
__device__ __forceinline__ u32x4 pack8(const float (&v)[8]) { u32x4 o; o.x = pkbf(v[0], v[1]); o.y = pkbf(v[2], v[3]); o.z = pkbf(v[4], v[5]); o.w = pkbf(v[6], v[7]); return o; }
__device__ __forceinline__ float sigm(float x) { return __builtin_amdgcn_rcpf(1.0f + __builtin_amdgcn_exp2f(-LOG2E * x)); }
__device__ __forceinline__ float silu(float x) { return x * sigm(x); }
__device__ __forceinline__ f32x4 silu4(const f32x4 g) {
    const f32x4 t = g * (-LOG2E);
    const f32x4 d = (f32x4){__builtin_amdgcn_exp2f(t[0]), __builtin_amdgcn_exp2f(t[1]), __builtin_amdgcn_exp2f(t[2]), __builtin_amdgcn_exp2f(t[3])} + 1.0f;
    return g * (f32x4){__builtin_amdgcn_rcpf(d[0]), __builtin_amdgcn_rcpf(d[1]), __builtin_amdgcn_rcpf(d[2]), __builtin_amdgcn_rcpf(d[3])};
}

__device__ __forceinline__ void transpose_item(const float* src, int ld_src, bf16_t* dst, int ld_dst, int k0, int n0s, int n0d, const float* kscale, const float* nscale, float mul, LAS float* scr, int lane) {
    float tv[32];
#pragma unroll
    for (int i = 0; i < 32; ++i) tv[i] = src[(size_t)(k0 + 2 * i + (lane >> 5)) * ld_src + n0s + (lane & 31)];
#pragma unroll
    for (int i = 0; i < 32; ++i) { const int kk = 2 * i + (lane >> 5); float v = tv[i]; if (kscale) v *= kscale[k0 + kk]; scr[kk * 33 + (lane & 31)] = v; }
    asm volatile("s_waitcnt lgkmcnt(0)" ::: "memory");
    const int c = lane & 7;
#pragma unroll
    for (int j = 0; j < 4; ++j) { const int n = (lane >> 3) + 8 * j; const LAS float* s = scr + (8 * c) * 33 + n; const float ns = (nscale ? nscale[n0s + n] : 1.0f) * mul;
        u32x4 o; o.x = pkbf(s[0 * 33] * ns, s[1 * 33] * ns); o.y = pkbf(s[2 * 33] * ns, s[3 * 33] * ns); o.z = pkbf(s[4 * 33] * ns, s[5 * 33] * ns); o.w = pkbf(s[6 * 33] * ns, s[7 * 33] * ns);
        *(u32x4*)(dst + (size_t)(n0d + n) * ld_dst + k0 + 8 * c) = o; }
    asm volatile("s_waitcnt lgkmcnt(0)" ::: "memory");
}
__device__ __forceinline__ const float* xrow_in(const Params& p, int row) { return row < MP ? p.xp + (size_t)row * D : p.xs + (size_t)(row - MP) * D; }

__device__ __forceinline__ void p0_phase(const Params& p, LAS unsigned char* lds, int gw, int NGW, int wid, int lane) {
    LAS float* scr = (LAS float*)(lds + wid * 8704);
    unsigned char* ws = p.ws;
    constexpr int I_IN = 16 * 128, I_OUT = 32 * 32, I_POOL = 4 * 4 * 8, I_G = 8 * 2 * 4, I_LAYER = I_IN + I_OUT + I_POOL + 2 * I_G;
    for (int it = gw; it < DEPTH * I_LAYER; it += NGW) {
        const int l = it / I_LAYER; int r = it % I_LAYER;
        if (r < I_IN) { const int kb = r / 128, nb = r % 128, n0s = nb * 32, blk = n0s >> 10, dblk = (blk == 1) ? 2 : (blk == 2 ? 1 : blk);
            transpose_item(p.w_in + (size_t)l * D * DIN, DIN, (bf16_t*)(ws + WS_WIN) + (size_t)l * DIN * D, D, kb * 64, n0s, dblk * 1024 + (n0s & 1023), p.norm_pre + l * D, nullptr, 1.0f, scr, lane); continue; }
        r -= I_IN;
        if (r < I_OUT) { const int kb = r / 32, nb = r % 32;
            transpose_item(p.w_out + (size_t)l * 2048 * D, D, (bf16_t*)(ws + WS_WOUT) + (size_t)l * D * 2048, 2048, kb * 64, nb * 32, nb * 32, nullptr, nullptr, 1.0f, scr, lane); continue; }
        r -= I_OUT;
        if (r < I_POOL) { const int g = r / 32, q = r % 32, kb = q / 8, nb = q % 8;
            transpose_item(p.pool_w + (size_t)(l * 4 + g) * 65536, 256, (bf16_t*)(ws + WS_POOLW) + (size_t)(l * 4 + g) * 65536, 256, kb * 64, nb * 32, nb * 32, nullptr, p.pool_scale + l * 1024 + g * 256, 1.0f, scr, lane); continue; }
        r -= I_POOL;
        { const bool isx = r >= I_G; if (isx) r -= I_G; const int h = r / 8, q = r % 8, kb = q / 4, nb = q % 4;
            transpose_item((isx ? p.lru_wx : p.lru_wa) + (size_t)(l * 8 + h) * 16384, 128, (bf16_t*)(ws + (isx ? WS_WX : WS_WA)) + (size_t)(l * 8 + h) * 16384, 128, kb * 64, nb * 32, nb * 32, nullptr, nullptr, -LOG2E, scr, lane); }
    }
    float* RINV = (float*)(ws + WS_RINV);
    bf16_t* XN = (bf16_t*)(ws + WS_XN);
    for (int row0 = 2 * gw; row0 < MT; row0 += 2 * NGW) {
        float v[2][2][8]; float ss[2] = {0.f, 0.f};
#pragma unroll
        for (int r = 0; r < 2; ++r) { const float* x = xrow_in(p, row0 + r);
#pragma unroll
            for (int j = 0; j < 2; ++j) ldf8(x + j * 512 + lane * 8, v[r][j]); }
#pragma unroll
        for (int r = 0; r < 2; ++r) {
#pragma unroll
            for (int j = 0; j < 2; ++j)
#pragma unroll
                for (int e = 0; e < 8; ++e) ss[r] += v[r][j][e] * v[r][j][e];
            const float rinv = __builtin_amdgcn_rsqf(wave_sum(ss[r], lane) * (1.0f / D) + EPS);
            if (lane == 0) RINV[row0 + r] = rinv;
#pragma unroll
            for (int j = 0; j < 2; ++j) *(u32x4*)(XN + (size_t)(row0 + r) * D + j * 512 + lane * 8) = pack8(v[r][j]); }
    }
    { float* LC = (float*)(ws + WS_LC);
      for (int i = gw * 64 + lane; i < DEPTH * 1024; i += NGW * 64) { const int l = i >> 10, c = i & 1023;
          LC[(l * 3 + 0) * 1024 + c] = -LOG2E * p.lru_ba[i]; LC[(l * 3 + 1) * 1024 + c] = -LOG2E * p.lru_bx[i]; LC[(l * 3 + 2) * 1024 + c] = -8.0f * LOG2E * log1pf(expf(-p.lru_lam[i])); } }
    gu64* carry = (gu64*)(ws + WS_CARRY);
    for (int i = gw * 64 + lane; i < DEPTH * NBP * NCHUNK * 1024; i += NGW * 64) __hip_atomic_store(carry + i, 0ull, RLX_AGENT);
}

template <int NP> __device__ __forceinline__ void f_phase(const Params& p, int l, int row_lo, int row_hi, int gw, int NGW, int lane) {
    bf16_t* X16 = (bf16_t*)(p.ws + WS_XN); const bf16_t* Z = (const bf16_t*)(p.ws + WS_Z); float* RINV = (float*)(p.ws + WS_RINV);
    const float* gpost = p.norm_post + l * D;
    float gp[2][8];
#pragma unroll
    for (int j = 0; j < 2; ++j) ldf8(gpost + j * 512 + lane * 8, gp[j]);
    for (int row0 = row_lo + 2 * gw; row0 < row_hi; row0 += 2 * NGW) {
        float o[2][2][8], v[2][2][8]; float so[2] = {0.f, 0.f}, sn[2] = {0.f, 0.f};
#pragma unroll
        for (int r = 0; r < 2; ++r) { const int row = row0 + r;
#pragma unroll
            for (int j = 0; j < 2; ++j) { ldbf8(Z + (size_t)row * DIN + ZV + j * 512 + lane * 8, o[r][j]); ldbf8(X16 + (size_t)row * D + j * 512 + lane * 8, v[r][j]);
                if (NP > 1) { float o2[8]; ldbf8(Z + (size_t)row * DIN + ZU + j * 512 + lane * 8, o2);
#pragma unroll
                    for (int e = 0; e < 8; ++e) o[r][j][e] += o2[e]; }
                if (NP > 2) {
#pragma unroll
                    for (int k = 0; k < NP - 2; ++k) { float o2[8]; ldbf8((const bf16_t*)(p.ws + WS_PART) + ((size_t)k * MS + (row - MP)) * D + j * 512 + lane * 8, o2);
#pragma unroll
                        for (int e = 0; e < 8; ++e) o[r][j][e] += o2[e]; } }
            } }
#pragma unroll
        for (int r = 0; r < 2; ++r)
#pragma unroll
            for (int j = 0; j < 2; ++j)
#pragma unroll
                for (int e = 0; e < 8; ++e) so[r] += o[r][j][e] * o[r][j][e];
#pragma unroll
        for (int r = 0; r < 2; ++r) { const int row = row0 + r;
            const float rn = __builtin_amdgcn_rsqf(wave_sum(so[r], lane) * (1.0f / D) + EPS);
#pragma unroll
            for (int j = 0; j < 2; ++j)
#pragma unroll
                for (int e = 0; e < 8; ++e) { v[r][j][e] = v[r][j][e] + o[r][j][e] * rn * gp[j][e]; sn[r] += v[r][j][e] * v[r][j][e]; }
            if (l < DEPTH - 1) {
                const float rinv = __builtin_amdgcn_rsqf(wave_sum(sn[r], lane) * (1.0f / D) + EPS);
                if (lane == 0) RINV[row] = rinv;
#pragma unroll
                for (int j = 0; j < 2; ++j) *(u32x4*)(X16 + (size_t)row * D + j * 512 + lane * 8) = pack8(v[r][j]);
            } else {
                float* y = p.out + (size_t)row * D;
#pragma unroll
                for (int j = 0; j < 2; ++j) { *(f32x4*)(y + j * 512 + lane * 8) = (f32x4){v[r][j][0], v[r][j][1], v[r][j][2], v[r][j][3]}; *(f32x4*)(y + j * 512 + lane * 8 + 4) = (f32x4){v[r][j][4], v[r][j][5], v[r][j][6], v[r][j][7]}; }
            }
        }
    }
}

constexpr int PA = 264, LA = 136;

template <bool SAMPLE, int G> __device__ __forceinline__ void pool_build_d(const Params& p, int l, int r0, LAS bf16_t* At, int tid) {
    constexpr int W = 2 << G, R = W + 7;
    const bf16_t* Z = (const bf16_t*)(p.ws + WS_Z);
    const int c8 = tid & 31, rseg = tid >> 5, ch = G * 256 + c8 * 8;
    const bf16_t* zseq; const float* st = nullptr; int j0;
    if (SAMPLE) { const int s = (r0 - MP) / TS + rseg; zseq = Z + (size_t)(MP + s * TS) * DIN + ZV + ch; st = p.st_pool + ((size_t)l * NBS + s) * 15 * 1024 + ch; j0 = 0; }
    else { const int b = r0 / SEQ; zseq = Z + (size_t)b * SEQ * DIN + ZV + ch; j0 = (r0 % SEQ) + rseg * 8; }
    u32x4 rows[R];
#pragma unroll
    for (int rr = 0; rr < R; ++rr) {
        const int j = j0 - (W - 1) + rr;
        if (SAMPLE) { if (rr >= W - 1) rows[rr] = *(const u32x4*)(zseq + (size_t)j * DIN); else { float t[8]; ldf8(st + (15 + j) * 1024, t); rows[rr] = pack8(t); } }
        else { rows[rr] = *(const u32x4*)(zseq + (size_t)(j < 0 ? 0 : j) * DIN); if (j < 0) rows[rr] = (u32x4){0u, 0u, 0u, 0u}; }
    }
    if (R == 9) asm volatile("" : "+v"(rows[0]), "+v"(rows[1]), "+v"(rows[2]), "+v"(rows[3]), "+v"(rows[4]), "+v"(rows[5]), "+v"(rows[6]), "+v"(rows[7]), "+v"(rows[8]));
    if (R >= 11) asm volatile("" : "+v"(rows[0]), "+v"(rows[1]), "+v"(rows[2]), "+v"(rows[3]), "+v"(rows[4]), "+v"(rows[5]), "+v"(rows[6]), "+v"(rows[7]), "+v"(rows[8]), "+v"(rows[9]), "+v"(rows[10]));
    if (R >= 15) asm volatile("" : "+v"(rows[(R >= 15) ? 11 : 0]), "+v"(rows[(R >= 15) ? 12 : 0]), "+v"(rows[(R >= 15) ? 13 : 0]), "+v"(rows[(R >= 15) ? 14 : 0]));
    if (R >= 23) asm volatile("" : "+v"(rows[(R >= 23) ? 15 : 0]), "+v"(rows[(R >= 23) ? 16 : 0]), "+v"(rows[(R >= 23) ? 17 : 0]), "+v"(rows[(R >= 23) ? 18 : 0]), "+v"(rows[(R >= 23) ? 19 : 0]), "+v"(rows[(R >= 23) ? 20 : 0]), "+v"(rows[(R >= 23) ? 21 : 0]), "+v"(rows[(R >= 23) ? 22 : 0]));
    float S[8];
#pragma unroll
    for (int e = 0; e < 8; ++e) S[e] = 0.f;
#pragma unroll
    for (int rr = 0; rr < R; ++rr) {
        float v[8]; unpack8(rows[rr], v);
#pragma unroll
        for (int e = 0; e < 8; ++e) S[e] += v[e];
        if (rr >= W - 1) {
            const int i = rr - (W - 1), j = j0 + i;
            const float rc = SAMPLE ? 1.0f / (float)W : __builtin_amdgcn_rcpf((float)min(j + 1, W));
            float dd[8], o[8];
#pragma unroll
            for (int e = 0; e < 8; ++e) dd[e] = S[e] * rc - v[e];
            *(LAS u32x4*)(At + (rseg * 8 + i) * PA + c8 * 8) = pack8(dd);
            unpack8(rows[rr - W + 1], o);
#pragma unroll
            for (int e = 0; e < 8; ++e) S[e] -= o[e];
        }
    }
}
template <bool SAMPLE> __device__ __forceinline__ void pool_job(const Params& p, int l, int r0, int g, LAS unsigned char* lds, const int wid) {
    bf16_t* Z = (bf16_t*)(p.ws + WS_Z);
    LAS bf16_t* At = (LAS bf16_t*)lds;
    bf16x8 bfr[8][2];
    {
        const int lane0 = fresh_lane(), r16 = lane0 & 15, q = lane0 >> 4;
        const bf16_t* Bw = (const bf16_t*)(p.ws + WS_POOLW) + ((size_t)(l * 4 + g) * 256 + wid * 32 + r16) * 256 + q * 8;
#pragma unroll
        for (int ks = 0; ks < 8; ++ks) { bfr[ks][0] = *(const bf16x8*)(Bw + ks * 32); bfr[ks][1] = *(const bf16x8*)(Bw + 16 * 256 + ks * 32); }
    }
    { const int tid = wid * 64 + fresh_lane();
    if (g == 0) pool_build_d<SAMPLE, 0>(p, l, r0, At, tid); else if (g == 1) pool_build_d<SAMPLE, 1>(p, l, r0, At, tid);
    else if (g == 2) pool_build_d<SAMPLE, 2>(p, l, r0, At, tid); else pool_build_d<SAMPLE, 3>(p, l, r0, At, tid); }
    __syncthreads();
    const int lane = fresh_lane(), r16 = lane & 15, q = lane >> 4;
    f32x4 acc[8][2];
#pragma unroll
    for (int m = 0; m < 8; ++m) { acc[m][0] = (f32x4){0.f, 0.f, 0.f, 0.f}; acc[m][1] = (f32x4){0.f, 0.f, 0.f, 0.f}; }
    const unsigned poff = (unsigned)(((r0 + r16) * DIN + ZGP + g * 256 + wid * 32 + q * 4) * 2);
    u32x2 gv[8][2];
#pragma unroll
    for (int m = 0; m < 8; ++m)
#pragma unroll
        for (int nb = 0; nb < 2; ++nb) gv[m][nb] = *(const u32x2*)((const char*)Z + (poff + (unsigned)(m * 16 * DIN * 2 + nb * 32)));
    f32x4 sv[8][2];
    __builtin_amdgcn_s_setprio(1);
#pragma unroll
    for (int ks = 0; ks < 8; ++ks) {
        const bf16x8 b0 = bfr[ks][0], b1 = bfr[ks][1];
#pragma unroll
        for (int m = 0; m < 8; ++m) { const bf16x8 a = *(const LAS bf16x8*)(At + (m * 16 + r16) * PA + ks * 32 + q * 8);
            acc[m][0] = __builtin_amdgcn_mfma_f32_16x16x32_bf16(b0, a, acc[m][0], 0, 0, 0); acc[m][1] = __builtin_amdgcn_mfma_f32_16x16x32_bf16(b1, a, acc[m][1], 0, 0, 0); }
#pragma unroll
        for (int nb = 0; nb < 2; ++nb) { const u32x2 gw2 = gv[ks][nb];
            sv[ks][nb] = silu4((f32x4){__uint_as_float(gw2.x << 16), __uint_as_float(gw2.x & 0xffff0000u), __uint_as_float(gw2.y << 16), __uint_as_float(gw2.y & 0xffff0000u)}); }
    }
    __builtin_amdgcn_s_setprio(0);
#pragma unroll
    for (int m = 0; m < 8; ++m)
#pragma unroll
        for (int nb = 0; nb < 2; ++nb) {
            bf16_t* zp = (bf16_t*)((char*)Z + (poff + (unsigned)(m * 16 * DIN * 2 + nb * 32)));
            const f32x4 yv = acc[m][nb] * sv[m][nb];
            u32x2 o; o.x = pkbf(yv[0], yv[1]); o.y = pkbf(yv[2], yv[3]);
            *(u32x2*)zp = o;
        }
    __syncthreads();
}

template <bool SAMPLE> __device__ __forceinline__ void conv_getrow(float (&v)[8], const bf16_t* zseq, const float* st, int j, int ch) {
    if (SAMPLE) { if (j >= 0) ldbf8(zseq + (size_t)j * DIN + ZU + ch, v); else ldf8(st + (3 + j) * 1024 + ch, v); }
    else {
        u32x4 w = *(const u32x4*)(zseq + (size_t)(j < 0 ? 0 : j) * DIN + ZU + ch);
        if (j < 0) w = (u32x4){0u, 0u, 0u, 0u};
        unpack8(w, v); }
}
__device__ __forceinline__ float chain_wait(gu64* slot) {
    unsigned long long x; unsigned spins = 0;
    for (;;) { x = __hip_atomic_load(slot, RLX_AGENT); if ((unsigned)(x >> 32) == CTAG) break; __builtin_amdgcn_s_sleep(2); if (++spins > (1u << 18)) { x = 0x7fc00000ull; break; } }
    return __uint_as_float((unsigned)x);
}
template <bool SAMPLE> __device__ __forceinline__ void lru_job(const Params& p, int l, int r0, int h, LAS unsigned char* lds, const int wid) {
    bf16_t* Z = (bf16_t*)(p.ws + WS_Z);
    LAS bf16_t* At = (LAS bf16_t*)lds;
    const int lane = fresh_lane(), tid = wid * 64 + lane;
    const int c = h * 128 + wid * 16 + (lane & 15);
    const float* LC = (const float*)(p.ws + WS_LC) + (size_t)l * 3 * 1024 + c;
    const float bav = LC[0], bxv = LC[1024], cl2 = LC[2048];
    bf16x8 wfa[4], wfx[4];
    {
        const bf16_t* Wa = (const bf16_t*)(p.ws + WS_WA) + ((size_t)(l * 8 + h) * 128 + wid * 16 + (lane & 15)) * 128 + (lane >> 4) * 8;
        const bf16_t* Wx = (const bf16_t*)(p.ws + WS_WX) + ((size_t)(l * 8 + h) * 128 + wid * 16 + (lane & 15)) * 128 + (lane >> 4) * 8;
#pragma unroll
        for (int ks = 0; ks < 4; ++ks) { wfa[ks] = *(const bf16x8*)(Wa + ks * 32); wfx[ks] = *(const bf16x8*)(Wx + ks * 32); }
    }
    {
        const int c8 = tid & 15, rseg = tid >> 4, ch = h * 128 + c8 * 8;
        const bf16_t* zseq; const float* st = nullptr; int j0;
        if (SAMPLE) { const int s = (r0 - MP) / TS + (rseg >> 1); zseq = Z + (size_t)(MP + s * TS) * DIN; st = p.st_conv + ((size_t)l * NBS + s) * 3 * 1024; j0 = (rseg & 1) * 4; }
        else { const int b = r0 / SEQ; zseq = Z + (size_t)b * SEQ * DIN; j0 = (r0 % SEQ) + rseg * 4; }
        float cw[4][8], y[4][8], u[8];
#pragma unroll
        for (int k = 0; k < 4; ++k) ldf8(p.conv_w + ((size_t)l * 4 + k) * 1024 + ch, cw[k]);
        ldf8(p.conv_b + (size_t)l * 1024 + ch, u);
#pragma unroll
        for (int i = 0; i < 4; ++i)
#pragma unroll
            for (int e = 0; e < 8; ++e) y[i][e] = u[e];
        u32x4 rw[7];
        if (!SAMPLE) {
#pragma unroll
            for (int e7 = 0; e7 < 7; ++e7) { const int j = j0 - 3 + e7; rw[e7] = *(const u32x4*)(zseq + (size_t)(j < 0 ? 0 : j) * DIN + ZU + ch); }
            asm volatile("" : "+v"(rw[0]), "+v"(rw[1]), "+v"(rw[2]), "+v"(rw[3]), "+v"(rw[4]), "+v"(rw[5]), "+v"(rw[6]));
        }
#pragma unroll
        for (int e7 = 0; e7 < 7; ++e7) {
            if (SAMPLE) conv_getrow<SAMPLE>(u, zseq, st, j0 - 3 + e7, ch);
            else { u32x4 w = rw[e7]; if (j0 - 3 + e7 < 0) w = (u32x4){0u, 0u, 0u, 0u}; unpack8(w, u); }
#pragma unroll
            for (int i = 0; i < 4; ++i) { const int k = e7 - i; if (k >= 0 && k < 4) {
#pragma unroll
                for (int e = 0; e < 8; ++e) y[i][e] += u[e] * cw[k][e]; } }
        }
#pragma unroll
        for (int i = 0; i < 4; ++i) *(LAS u32x4*)(At + (rseg * 4 + i) * LA + c8 * 8) = pack8(y[i]);
    }
    __syncthreads();
    const int r16 = lane & 15, q = lane >> 4;
    f32x4 aa[8], ax[8];
#pragma unroll
    for (int m = 0; m < 8; ++m) { aa[m] = (f32x4){0.f, 0.f, 0.f, 0.f}; ax[m] = (f32x4){0.f, 0.f, 0.f, 0.f}; }
    {
        __builtin_amdgcn_s_setprio(1);
#pragma unroll
        for (int ks = 0; ks < 4; ++ks) {
            const bf16x8 ba = wfa[ks], bx = wfx[ks];
#pragma unroll
            for (int m = 0; m < 8; ++m) { const bf16x8 a = *(const LAS bf16x8*)(At + (m * 16 + r16) * LA + ks * 32 + q * 8);
                aa[m] = __builtin_amdgcn_mfma_f32_16x16x32_bf16(a, ba, aa[m], 0, 0, 0); ax[m] = __builtin_amdgcn_mfma_f32_16x16x32_bf16(a, bx, ax[m], 0, 0, 0); }
        }
        __builtin_amdgcn_s_setprio(0);
    }
    const int t0 = SAMPLE ? 1 : (r0 % SEQ);
    typedef float f32x2 __attribute__((ext_vector_type(2)));
#pragma unroll
    for (int m = 0; m < 8; ++m)
#pragma unroll
        for (int ip = 0; ip < 4; ip += 2) {
            const int rl = m * 16 + q * 4 + ip;
            const f32x2 xs = {bf2f((unsigned)At[rl * LA + wid * 16 + r16]), bf2f((unsigned)At[(rl + 1) * LA + wid * 16 + r16])};
            const f32x2 za = (f32x2){aa[m][ip], aa[m][ip + 1]} + bav, zx = (f32x2){ax[m][ip], ax[m][ip + 1]} + bxv;
            const f32x2 da = (f32x2){__builtin_amdgcn_exp2f(za.x), __builtin_amdgcn_exp2f(za.y)} + 1.0f, dx = (f32x2){__builtin_amdgcn_exp2f(zx.x), __builtin_amdgcn_exp2f(zx.y)} + 1.0f;
            const f32x2 r = {__builtin_amdgcn_rcpf(da.x), __builtin_amdgcn_rcpf(da.y)}, gi = {__builtin_amdgcn_rcpf(dx.x), __builtin_amdgcn_rcpf(dx.y)};
            const f32x2 la = r * cl2;
            const f32x2 a = {__builtin_amdgcn_exp2f(la.x), __builtin_amdgcn_exp2f(la.y)};
            const f32x2 om = (f32x2){1.0f, 1.0f} - a * a;
            f32x2 mult = {__builtin_amdgcn_sqrtf(fmaxf(om.x, 1e-12f)), __builtin_amdgcn_sqrtf(fmaxf(om.y, 1e-12f))};
            if (!SAMPLE && m == 0 && ip == 0) { if (t0 + rl == 0) mult.x = 1.0f; }
            const f32x2 u = xs * gi * mult;
            aa[m][ip] = a.x; aa[m][ip + 1] = a.y; ax[m][ip] = u.x; ax[m][ip + 1] = u.y;
        }
    asm volatile("" ::: "memory");
    const unsigned goff = (unsigned)(((r0 + q * 4) * DIN + ZGL + c) * 2);
    unsigned short glv[8][4];
#pragma unroll
    for (int m = 0; m < 8; ++m)
#pragma unroll
        for (int i = 0; i < 4; ++i) glv[m][i] = *(const unsigned short*)((const char*)Z + (goff + (unsigned)((m * 16 + i) * DIN * 2)));
    float* outp = p.out;
    if (SAMPLE) {
        const int s0 = (r0 - MP) / TS;
#pragma unroll
        for (int m = 0; m < 8; ++m) {
            float P = 1.f, H = 0.f;
#pragma unroll
            for (int i = 0; i < 4; ++i) { H = aa[m][i] * H + ax[m][i]; P *= aa[m][i]; ax[m][i] = H; aa[m][i] = P; }
            const float P1 = shfl_lane(P, (lane - 16) & 63), H1 = shfl_lane(H, (lane - 16) & 63);
            const int s = s0 + m * 2 + (q >> 1);
            const float h0 = p.st_lru[((size_t)l * NBS + s) * 1024 + c];
            const float QH = (q & 1) ? (P1 * h0 + H1) : h0;
#pragma unroll
            for (int i = 0; i < 4; i += 4) ax[m] = aa[m] * QH + ax[m];
            if (q & 1) outp[O_LS + ((size_t)l * NBS + s) * 1024 + c] = ax[m][3];
        }
    } else {
        float cP = 1.f, cH = 0.f;
#pragma unroll
        for (int m = 0; m < 8; ++m) {
            float P = 1.f, H = 0.f;
#pragma unroll
            for (int i = 0; i < 4; ++i) { H = aa[m][i] * H + ax[m][i]; P *= aa[m][i]; ax[m][i] = H; aa[m][i] = P; }
            float EP = 1.f, EH = 0.f;
#pragma unroll
            for (int d = 3; d >= 1; --d) { const float Pd = shfl_lane(P, (lane - 16 * d) & 63), Hd = shfl_lane(H, (lane - 16 * d) & 63); if (q >= d) { EH = Pd * EH + Hd; EP = Pd * EP; } }
            float TP = P * EP, TH = P * EH + H;
            TP = shfl_lane(TP, 48 + r16); TH = shfl_lane(TH, 48 + r16);
            const float QH = EP * cH + EH, QP = EP * cP;
#pragma unroll
            for (int i = 0; i < 4; i += 4) { ax[m] = aa[m] * QH + ax[m]; aa[m] = aa[m] * QP; }
            cH = TP * cH + TH; cP = TP * cP;
        }
        const int b = r0 / SEQ, tch = (r0 % SEQ) / 128;
        gu64* agg = (gu64*)(p.ws + WS_CARRY) + (((size_t)l * NBP + b) * NCHUNK) * 1024 + c;
        if (q == 0 && tch < NCHUNK - 1) __hip_atomic_store(agg + (size_t)tch * 1024, ((unsigned long long)__float_as_uint(cP) << 32) | (unsigned long long)__float_as_uint(cH), RLX_AGENT);
        float h_in = 0.f;
        if (tch > 0) {
            unsigned long long x[NCHUNK - 1];
            for (unsigned spins = 0;;) {
                bool ok = true;
#pragma unroll
                for (int k = 0; k < NCHUNK - 1; ++k) if (k < tch) { x[k] = __hip_atomic_load(agg + (size_t)k * 1024, RLX_AGENT); ok = ok && ((unsigned)(x[k] >> 32) != 0u); }
                if (__all(ok)) break;
                __builtin_amdgcn_s_sleep(2);
                if (++spins > (1u << 18)) break;
            }
#pragma unroll
            for (int k = 0; k < NCHUNK - 1; ++k) if (k < tch) h_in = __uint_as_float((unsigned)(x[k] >> 32)) * h_in + __uint_as_float((unsigned)x[k]);
        }
        if (q == 0 && tch == NCHUNK - 1) outp[O_LP + ((size_t)l * NBP + b) * 1024 + c] = cP * h_in + cH;
#pragma unroll
        for (int m = 0; m < 8; ++m)
#pragma unroll
            for (int i = 0; i < 4; i += 4) ax[m] = aa[m] * h_in + ax[m];
    }
#pragma unroll
    for (int m = 0; m < 8; ++m) {
        const f32x4 yv = ax[m] * silu4((f32x4){bf2f((unsigned)glv[m][0]), bf2f((unsigned)glv[m][1]), bf2f((unsigned)glv[m][2]), bf2f((unsigned)glv[m][3])});
        const unsigned w01 = pkbf(yv[0], yv[1]), w23 = pkbf(yv[2], yv[3]);
        *(bf16_t*)((char*)Z + (goff + (unsigned)((m * 16 + 0) * DIN * 2))) = (bf16_t)(w01 & 0xffffu);
        *(bf16_t*)((char*)Z + (goff + (unsigned)((m * 16 + 1) * DIN * 2))) = (bf16_t)(w01 >> 16);
        *(bf16_t*)((char*)Z + (goff + (unsigned)((m * 16 + 2) * DIN * 2))) = (bf16_t)(w23 & 0xffffu);
        *(bf16_t*)((char*)Z + (goff + (unsigned)((m * 16 + 3) * DIN * 2))) = (bf16_t)(w23 >> 16);
    }
    __syncthreads();
}

#ifndef G_ALIGN
#define G_ALIGN true
#endif
#ifndef G_SP2
#define G_SP2 true
#endif
struct EpiStore {
    static constexpr bool PERM = true, AFTER_DRAIN = false;
    bf16_t* O; int ldc; const float* rscale;
    __device__ __forceinline__ void operator()(const f32x4 (&acc)[2][2][4][2], const pg8::Unit& u, int wr, int wc, int fr, int fq) const {
        const int row0 = u.pm * pg8::BM + wr * 64 + fr;
        const __amdgpu_buffer_rsrc_t rs = __builtin_amdgcn_make_buffer_rsrc((void*)O, (short)0, 0x7ffffff0, 0x00020000);
        const unsigned off0 = (unsigned)((row0 * ldc + u.pn * pg8::BM + wc * 32 + 8 * fq) * 2);
#pragma unroll
        for (int ai = 0; ai < 2; ++ai)
#pragma unroll
            for (int m = 0; m < 4; ++m) { const unsigned offr = off0 + (unsigned)((ai * pg8::HALF + m * 16) * ldc * 2);
                const float s = rscale ? rscale[row0 + ai * pg8::HALF + m * 16] : 1.0f;
#pragma unroll
                for (int bj = 0; bj < 2; ++bj) { const f32x4 v0 = acc[ai][bj][m][0] * s, v1 = acc[ai][bj][m][1] * s;
                    u32x4 w; w.x = pkbf(v0[0], v0[1]); w.y = pkbf(v0[2], v0[3]); w.z = pkbf(v1[0], v1[1]); w.w = pkbf(v1[2], v1[3]);
                    __builtin_amdgcn_raw_buffer_store_b128(w, rs, offr + (unsigned)(bj * pg8::HALF * 2), 0, 16); } }
    }
};
struct OneUnit {
    int pm, pn;
    __device__ __forceinline__ bool next(int i, pg8::Unit& u) const { if (i != 0) return false; u.pm = pm; u.pn = pn; return true; }
    __device__ __forceinline__ void a_ready(const pg8::Unit&) const {}
    __device__ __forceinline__ void done(const pg8::Unit&) const {}
};
__device__ __forceinline__ void m_phase(const Params& p, int l, LAS unsigned char* lds, const int wid) {
    constexpr int NG1 = (MS / 256) * (DIN / 256), NPJ = (MP / 128) * 12, NJOB = (MT / 128) * 12;
    unsigned* g1done = (unsigned*)(p.ws + WS_Q) + 64 * l;
    int G = (int)gridDim.x; asm volatile("" : "+s"(G));
    const int w = (int)blockIdx.x;
    const bool sched256 = (G == 256);
    bool acq = false;
    for (int it = 0;; ++it) {
        int cur, unit = -1;
        if (sched256) { if (w < NG1) { if (it == 0) { unit = w; cur = 0; } else cur = 2 * (256 - NG1) + (it - 1) * 256 + w; }
                        else cur = it < 2 ? it * (256 - NG1) + (w - NG1) : 2 * (256 - NG1) + (it - 2) * 256 + w; }
        else { const int nu = (NG1 - w + G - 1) / G; if (it < nu) { unit = w + it * G; cur = 0; } else cur = w + (it - nu) * G; }
        if (unit < 0 && cur >= NJOB) break;
        if (unit >= 0) {
            pg8::Gemm g{(const bf16_t*)(p.ws + WS_XN) + (size_t)MP * D, (const bf16_t*)(p.ws + WS_WIN) + (size_t)l * DIN * D, MS, DIN};
            OneUnit S{unit / (DIN / 256), unit % (DIN / 256)};
            EpiStore E{(bf16_t*)(p.ws + WS_Z) + (size_t)MP * DIN, DIN, (const float*)(p.ws + WS_RINV) + MP};
            pg8::gemm_phase<EpiStore, OneUnit, D, D, D, false, G_SP2>(lds, g, S, E, wid * 64 + fresh_lane());
            asm volatile("s_waitcnt vmcnt(0)" ::: "memory");
            __syncthreads();
            if (wid == 0 && fresh_lane() == 0) __hip_atomic_fetch_add(g1done, 1u, RLX_AGENT);
        } else if (cur < NPJ) { const int tch = cur / 96, rem = cur % 96, b = rem / 12, sub = rem % 12, r0 = b * SEQ + tch * 128;
            if (sub < 4) pool_job<false>(p, l, r0, sub, lds, wid); else lru_job<false>(p, l, r0, sub - 4, lds, wid);
        } else { const int jj = cur - NPJ, tile = jj / 12, sub = jj % 12, r0 = MP + tile * 128;
            if (!acq) {
            if (wid == 0) { unsigned spins = 0; while ((unsigned)__builtin_amdgcn_readfirstlane(__hip_atomic_load(g1done, RLX_AGENT)) < (unsigned)NG1) { __builtin_amdgcn_s_sleep(2); if (++spins > (1u << 18)) break; }
                __builtin_amdgcn_fence(__ATOMIC_ACQUIRE, "agent"); asm volatile("s_waitcnt vmcnt(0)" ::: "memory"); }
            __syncthreads(); acq = true; }
            if (sub < 4) pool_job<true>(p, l, r0, sub, lds, wid); else lru_job<true>(p, l, r0, sub - 4, lds, wid);
        }
    }
    const bf16_t* Z = (const bf16_t*)(p.ws + WS_Z);
    if (G == 256 && w >= NG1 && w < 224) return;
    const int tid = wid * 64 + fresh_lane();
    if (!acq) {
    if (wid == 0) { unsigned spins = 0; while ((unsigned)__builtin_amdgcn_readfirstlane(__hip_atomic_load(g1done, RLX_AGENT)) < (unsigned)NG1) { __builtin_amdgcn_s_sleep(2); if (++spins > (1u << 18)) break; }
        __builtin_amdgcn_fence(__ATOMIC_ACQUIRE, "agent"); asm volatile("s_waitcnt vmcnt(0)" ::: "memory"); }
    }
    __syncthreads();
    constexpr int U_PP = NBP * 15 * 128, U_CP = NBP * 3 * 128, U_PS = NBS * 15 * 128, U_CS = NBS * 3 * 128, U_ALL = U_PP + U_CP + U_PS + U_CS;
    const bool s256 = (G == 256);
    if (s256 && w >= NG1 && w < 224) return;
    const int cw = s256 ? (w < NG1 ? w : w - 224 + NG1) : w, ncw = s256 ? NG1 + 32 : G;
    const int nthr = ncw * NTHREADS;
    for (int u0 = cw * NTHREADS + tid; u0 < U_ALL; u0 += 3 * nthr) {
        u32x4 ra[3], rb[3]; float* dst[3]; bool isf[3];
#pragma unroll
        for (int k = 0; k < 3; ++k) {
            int r = u0 + k * nthr; const void* src; isf[k] = false; dst[k] = nullptr;
            if (r >= U_ALL) { src = Z; }
            else if (r < U_PP) { const int c8 = r & 127, rr = (r >> 7) % 15, b = (r >> 7) / 15; src = Z + (size_t)(b * SEQ + SEQ - 15 + rr) * DIN + ZV + c8 * 8; dst[k] = p.out + O_PP + (((size_t)l * NBP + b) * 15 + rr) * 1024 + c8 * 8; }
            else if ((r -= U_PP) < U_CP) { const int c8 = r & 127, rr = (r >> 7) % 3, b = (r >> 7) / 3; src = Z + (size_t)(b * SEQ + SEQ - 3 + rr) * DIN + ZU + c8 * 8; dst[k] = p.out + O_CP + (((size_t)l * NBP + b) * 3 + rr) * 1024 + c8 * 8; }
            else if ((r -= U_CP) < U_PS) { const int c8 = r & 127, rr = (r >> 7) % 15, s = (r >> 7) / 15;
                if (rr < 7) { src = p.st_pool + (((size_t)l * NBS + s) * 15 + 8 + rr) * 1024 + c8 * 8; isf[k] = true; } else src = Z + (size_t)(MP + s * TS + rr - 7) * DIN + ZV + c8 * 8;
                dst[k] = p.out + O_PS + (((size_t)l * NBS + s) * 15 + rr) * 1024 + c8 * 8; }
            else { r -= U_PS; const int c8 = r & 127, rr = (r >> 7) % 3, s = (r >> 7) / 3; src = Z + (size_t)(MP + s * TS + 5 + rr) * DIN + ZU + c8 * 8; dst[k] = p.out + O_CS + (((size_t)l * NBS + s) * 3 + rr) * 1024 + c8 * 8; }
            ra[k] = *(const u32x4*)src; rb[k] = ra[k]; if (isf[k]) rb[k] = *((const u32x4*)src + 1);
        }
#pragma unroll
        for (int k = 0; k < 3; ++k) if (dst[k]) {
            if (isf[k]) { *(u32x4*)dst[k] = ra[k]; *(u32x4*)(dst[k] + 4) = rb[k]; }
            else { float v[8]; unpack8(ra[k], v); *(f32x4*)dst[k] = (f32x4){v[0], v[1], v[2], v[3]}; *(f32x4*)(dst[k] + 4) = (f32x4){v[4], v[5], v[6], v[7]}; }
        }
    }
}

#define XB_TMO      128
#define XB_XCNT(j)  (256  + 64 * (j))
#define XB_XSUB(j)  (1280 + 64 * (j))
#define XB_XGEN(j)  (2304 + 64 * (j))
#define XB_TOP      3328
#define XB_TOPGEN   3392
#define XCD_BAR_WORDS 3456
#define XB_SPIN_CAP (1u << 18)

__device__ __forceinline__ unsigned xb_ld(unsigned* p)              { return __hip_atomic_load(p, __ATOMIC_RELAXED, __HIP_MEMORY_SCOPE_AGENT); }
__device__ __forceinline__ unsigned xb_add(unsigned* p, unsigned v) { return __hip_atomic_fetch_add(p, v, __ATOMIC_RELAXED, __HIP_MEMORY_SCOPE_AGENT); }
__device__ __forceinline__ unsigned xb_xcc_id() { return (unsigned)__builtin_amdgcn_s_getreg((3 << 11) | 20) & 0xFu; }
#define XB_SPIN(cond, bar) do { unsigned _sp = 0; while (cond) { __builtin_amdgcn_s_sleep(1); \
    if ((++_sp & 255u) == 0u) { if (xb_ld(&(bar)[XB_TMO])) break; if (_sp > XB_SPIN_CAP) { atomicAdd(&(bar)[XB_TMO], 1u); break; } } } } while (0)

struct XcdBarrier {
    unsigned* bar; unsigned x;
    volatile LAS unsigned* st;
};

__device__ __forceinline__ XcdBarrier xcd_barrier_post(unsigned* bar, volatile LAS unsigned* st, bool leader) {
    XcdBarrier b; b.bar = bar; b.x = xb_xcc_id(); b.st = st;
    if (leader) (void)xb_add(&bar[XB_XCNT(b.x)], 1u);
    return b;
}
__device__ __forceinline__ void xcd_barrier_complete(unsigned* bar, unsigned x, unsigned& nloc, unsigned& nx) {
    const unsigned G = gridDim.x * gridDim.y * gridDim.z;
    unsigned sum, cnt, mine, sp = 0u;
    for (;;) {
        sum = 0u; cnt = 0u; mine = 0u;
#pragma unroll
        for (unsigned j = 0; j < 16; ++j) { const unsigned c = xb_ld(&bar[XB_XCNT(j)]); sum += c; cnt += (c > 0u) ? 1u : 0u; mine = (j == x) ? c : mine; }
        if (sum == G) break;
        __builtin_amdgcn_s_sleep(1);
        if ((++sp & 255u) == 0u) { if (xb_ld(&bar[XB_TMO])) break; if (sp > XB_SPIN_CAP) { atomicAdd(&bar[XB_TMO], 1u); break; } }
    }
    nloc = mine > 0u ? mine : 1u; nx = cnt > 0u ? cnt : 1u;
}

__device__ __forceinline__ void xcd_barrier(const XcdBarrier& b, bool leader) {
    asm volatile("s_waitcnt vmcnt(0)" ::: "memory");
    __syncthreads();
    if (leader) {
        unsigned* bar = b.bar;
        __builtin_amdgcn_s_waitcnt(0);
        unsigned nloc = b.st[0], nx = b.st[1];
        if (nloc == 0u) { xcd_barrier_complete(bar, b.x, nloc, nx); b.st[0] = nloc; b.st[1] = nx; }
        const unsigned old = xb_add(&bar[XB_XSUB(b.x)], 1u);
        const unsigned gen = old / nloc;
        if (old + 1u == (gen + 1u) * nloc) {
            __builtin_amdgcn_fence(__ATOMIC_RELEASE, "agent");
            asm volatile("s_waitcnt vmcnt(0)" ::: "memory");
            const unsigned og = xb_add(&bar[XB_TOP], 1u);
            const unsigned tg = og / nx;
            if (og + 1u == (tg + 1u) * nx) xb_add(&bar[XB_TOPGEN], 1u);
            else XB_SPIN(xb_ld(&bar[XB_TOPGEN]) == tg, bar);
            __builtin_amdgcn_fence(__ATOMIC_ACQUIRE, "agent");
            xb_add(&bar[XB_XGEN(b.x)], 1u);
            asm volatile("s_waitcnt vmcnt(0)" ::: "memory");
        } else {
            XB_SPIN(xb_ld(&bar[XB_XGEN(b.x)]) == gen, bar);
            __builtin_amdgcn_fence(__ATOMIC_ACQUIRE, "agent");
            asm volatile("s_waitcnt vmcnt(0)" ::: "memory");
        }
    }
    __syncthreads();
}

__global__ void __launch_bounds__(NTHREADS, 2) hymba_fwd(Params p) {
    extern __shared__ __attribute__((aligned(16))) unsigned char lds_raw[];
    LAS unsigned char* lds = (LAS unsigned char*)lds_raw;
    cg::grid_group grid = cg::this_grid();
    const int G = gridDim.x, NGW = G * NWAVES;
#define FT() (wid_s * 64 + fresh_lane())
    const int wid_s = __builtin_amdgcn_readfirstlane((int)threadIdx.x >> 6);
#define FRESH_TID() int wid_o = wid_s; asm volatile("" : "+s"(wid_o)); const int lane = fresh_lane(), wid = wid_o, tid = wid * 64 + lane, gw = blockIdx.x * NWAVES + wid; (void)gw; (void)tid
    bf16_t* XN = (bf16_t*)(p.ws + WS_XN); bf16_t* Z = (bf16_t*)(p.ws + WS_Z);

    if (blockIdx.x == 0) { for (int i = FT(); i < XCD_BAR_WORDS; i += NTHREADS) __hip_atomic_store((unsigned*)(p.ws + WS_BAR) + i, 0u, RLX_AGENT);
        if (FT() < 8) __hip_atomic_store((unsigned*)(p.ws + WS_Q) + 64 * FT(), 0u, RLX_AGENT); }
    if (FT() < 2) ((volatile LAS unsigned*)(lds + 131072))[FT()] = 0u;
    grid.sync();
    const XcdBarrier xbar = xcd_barrier_post((unsigned*)(p.ws + WS_BAR), (volatile LAS unsigned*)(lds + 131072), FT() == 0);
#ifndef NO_P0
    { FRESH_TID(); p0_phase(p, lds, gw, NGW, wid, lane); }
#endif
    xcd_barrier(xbar, FT() == 0);
#pragma unroll 1
    for (int l = 0; l < DEPTH; ++l) {
        {
            pg8::Gemm g{XN, (const bf16_t*)(p.ws + WS_WIN) + (size_t)l * DIN * D, MP, DIN};
            pg8::StaticOrder S; S.init(MP, DIN, G, (int)blockIdx.x);
            EpiStore E{Z, DIN, (const float*)(p.ws + WS_RINV)};
            pg8::gemm_phase<EpiStore, pg8::StaticOrder, D, D, D, G_ALIGN, G_SP2>(lds, g, S, E, FT());
        }
        xcd_barrier(xbar, FT() == 0);
#ifndef NO_M
        m_phase(p, l, lds, wid_s);
#endif
        xcd_barrier(xbar, FT() == 0);
        {
            pg8::Gemm g{Z + ZGP, (const bf16_t*)(p.ws + WS_WOUT) + (size_t)l * D * 2048, MP, D};
            pg8::StaticOrder S; S.init(MP, D, G, (int)blockIdx.x);
            EpiStore E{Z + ZV, DIN, nullptr};
            pg8::gemm_phase<EpiStore, pg8::StaticOrder, 2048, DIN, 2048, G_ALIGN, G_SP2>(lds, g, S, E, FT());
        }
        xcd_barrier(xbar, FT() == 0);
        constexpr int NSG = (MS / 256) * (D / 256), KS = 4;
        int Gl = G; asm volatile("" : "+s"(Gl));
        if (Gl > 2 * KS * NSG) {
            if ((int)blockIdx.x < KS * NSG) {
                const int ks = (int)blockIdx.x / NSG;
                pg8::Gemm g{Z + (size_t)MP * DIN + ZGP + ks * (2048 / KS), (const bf16_t*)(p.ws + WS_WOUT) + (size_t)l * D * 2048 + ks * (2048 / KS), MS, D};
                pg8::StaticOrder S; S.init(MS, D, NSG, (int)blockIdx.x % NSG);
                EpiStore E{ks < 2 ? Z + (size_t)MP * DIN + (ks ? ZU : ZV) : (bf16_t*)(p.ws + WS_PART) + (size_t)(ks - 2) * MS * D, ks < 2 ? DIN : D, nullptr};
                pg8::gemm_phase<EpiStore, pg8::StaticOrder, 2048 / KS, DIN, 2048, G_ALIGN, G_SP2>(lds, g, S, E, FT());
                unsigned* fsdone = (unsigned*)(p.ws + WS_Q) + 64 * (4 + l);
                asm volatile("s_waitcnt vmcnt(0)" ::: "memory");
                __syncthreads();
                if (FT() == 0) __hip_atomic_fetch_add(fsdone, 1u, RLX_AGENT);
                if (wid_s == 0) { unsigned spins = 0; while ((unsigned)__builtin_amdgcn_readfirstlane(__hip_atomic_load(fsdone, RLX_AGENT)) < (unsigned)(KS * NSG)) { __builtin_amdgcn_s_sleep(2); if (++spins > (1u << 18)) break; }
                    __builtin_amdgcn_fence(__ATOMIC_ACQUIRE, "agent"); asm volatile("s_waitcnt vmcnt(0)" ::: "memory"); }
                __syncthreads();
                { FRESH_TID(); f_phase<4>(p, l, MP, MT, gw, KS * NSG * NWAVES, lane); }
            } else {
                FRESH_TID(); f_phase<1>(p, l, 0, MP, gw - KS * NSG * NWAVES, NGW - KS * NSG * NWAVES, lane);
            }
        } else {
            for (int ks = 0; ks < KS; ++ks) { pg8::Gemm g{Z + (size_t)MP * DIN + ZGP + ks * (2048 / KS), (const bf16_t*)(p.ws + WS_WOUT) + (size_t)l * D * 2048 + ks * (2048 / KS), MS, D};
              pg8::StaticOrder S; S.init(MS, D, G, (int)blockIdx.x);
              EpiStore E{ks < 2 ? Z + (size_t)MP * DIN + (ks ? ZU : ZV) : (bf16_t*)(p.ws + WS_PART) + (size_t)(ks - 2) * MS * D, ks < 2 ? DIN : D, nullptr};
              pg8::gemm_phase<EpiStore, pg8::StaticOrder, 2048 / KS, DIN, 2048, G_ALIGN, G_SP2>(lds, g, S, E, FT()); }
            { FRESH_TID(); f_phase<1>(p, l, 0, MP, gw, NGW, lane); }
            xcd_barrier(xbar, FT() == 0);
            { FRESH_TID(); f_phase<4>(p, l, MP, MT, gw, NGW, lane); }
        }
        if (l < DEPTH - 1) xcd_barrier(xbar, FT() == 0);
    }
}

extern "C" void kernel_launch(void* const* d_in, const int* in_sizes, int n_in, void* d_out, int out_size, void* d_ws, size_t ws_size, hipStream_t stream) {
    static int grid = 0;
    if (grid == 0) {
        if (n_in != 18 || (size_t)out_size != O_END || ws_size < WS_BAR + 65536) { fprintf(stderr, "kernel_launch: unexpected shapes (n_in %d out %d ws %zu)\n", n_in, out_size, ws_size); grid = -1; return; }
        int dev = 0, cus = 0, per_cu = 0;
        if (hipGetDevice(&dev) != hipSuccess || hipDeviceGetAttribute(&cus, hipDeviceAttributeMultiprocessorCount, dev) != hipSuccess) { grid = -1; return; }
        if (hipFuncSetAttribute((const void*)hymba_fwd, hipFuncAttributeMaxDynamicSharedMemorySize, LDS_BYTES) != hipSuccess) { fprintf(stderr, "kernel_launch: hipFuncSetAttribute failed\n"); grid = -1; return; }
        if (hipOccupancyMaxActiveBlocksPerMultiprocessor(&per_cu, (const void*)hymba_fwd, NTHREADS, LDS_BYTES) != hipSuccess || per_cu < 1) { fprintf(stderr, "kernel_launch: occupancy query failed (%d)\n", per_cu); grid = -1; return; }
        grid = cus * per_cu;
    }
    if (grid < 0) return;
    Params p{};
    p.xp = (const float*)d_in[0]; p.xs = (const float*)d_in[1]; p.st_pool = (const float*)d_in[2]; p.st_conv = (const float*)d_in[3]; p.st_lru = (const float*)d_in[4];
    p.norm_pre = (const float*)d_in[5]; p.norm_post = (const float*)d_in[6]; p.w_in = (const float*)d_in[7]; p.pool_w = (const float*)d_in[8]; p.pool_scale = (const float*)d_in[9];
    p.conv_w = (const float*)d_in[10]; p.conv_b = (const float*)d_in[11]; p.lru_wa = (const float*)d_in[12]; p.lru_ba = (const float*)d_in[13]; p.lru_wx = (const float*)d_in[14];
    p.lru_bx = (const float*)d_in[15]; p.lru_lam = (const float*)d_in[16]; p.w_out = (const float*)d_in[17]; p.out = (float*)d_out; p.ws = (unsigned char*)d_ws;
    void* args[] = {&p};
    hipError_t e = hipLaunchCooperativeKernel((const void*)hymba_fwd, dim3(grid), dim3(NTHREADS), args, LDS_BYTES, stream);
    if (e != hipSuccess) fprintf(stderr, "kernel_launch: cooperative launch failed: %s (grid %d)\n", hipGetErrorString(e), grid);
}
```
